# Optimizing an MI355X kernel written in HIP

```python
import math
import jax
import jax.numpy as jnp
from jax import lax
import numpy as np

D_MODEL = 1024
BATCH = 8
SEQ = 8192
DEPTH = 4
DEC_BATCH = 4
DEC_SEQ = 4096
PAST_LEN = 128

EPS = 1e-6
D_HY = D_MODEL // 2
HY_GROUPS = 8
N_FILT = 2
SHORT_K = 3
EMB_DIM = 33
N_BANDS = (EMB_DIM - 1) // 2
FILT_HID = 64
FILT_TAP_SCALE = 0.04
DECAY_FAST = 0.3
DECAY_SLOW = 1.5
DECAY_TARGET = 1e-2
HY_COLS = (N_FILT + 1) * D_HY
N_HEADS = 8
NOPE_DIM = 64
ROPE_DIM = 32
V_DIM = 64
Q_LORA = 384
KV_LORA = 256
ROPE_THETA = 10000.0
Q_BLOCK = 128
POOL_WINDOWS = (2, 4, 8, 16)
N_POOL_GROUPS = 4
POOL_GRP = D_MODEL // N_POOL_GROUPS
D_FF = 4 * D_MODEL
IN_COLS = HY_COLS + Q_LORA + KV_LORA + ROPE_DIM
MIX_WIDTH = D_HY + N_HEADS * V_DIM
N_EVEN = (DEPTH + 1) // 2
N_ODD = DEPTH // 2

kernel_name = 'hybrid_hyena_mla_pool_encoder'


def rmsnorm(x, g):
    xf = x.astype(jnp.float32)
    y = xf * lax.rsqrt(jnp.mean(xf * xf, axis=-1, keepdims=True) + EPS)
    return (y * g.astype(jnp.float32)).astype(x.dtype)


def short_conv(u, w, b):
    up = jnp.pad(u, ((0, 0), (1, 1), (0, 0)))
    return up[:, :-2] * w[0] + up[:, 1:-1] * w[1] + up[:, 2:] * w[2] + b


def hyena_filters(L, w1, b1, freq, w2, b2, w3):
    f32 = jnp.float32
    t = jnp.linspace(0.0, 1.0, L, dtype=f32)[:, None]
    wpos = (2.0 * math.pi / L) * jnp.arange(L, dtype=f32)[:, None]
    bands = jnp.linspace(1e-4, N_BANDS - 1, N_BANDS, dtype=f32)[None, :]
    z = jnp.concatenate([t, jnp.cos(bands * wpos), -jnp.sin(bands * wpos)], axis=-1)
    fr = freq.astype(f32)
    h = jnp.sin(fr * (z @ w1.astype(f32) + b1.astype(f32)))
    h = jnp.sin(fr * (h @ w2.astype(f32) + b2.astype(f32)))
    h = (h @ w3.astype(f32)).reshape(L, 2, N_FILT, D_HY)
    max_decay = math.log(DECAY_TARGET) / DECAY_FAST
    min_decay = math.log(DECAY_TARGET) / DECAY_SLOW
    deltas = jnp.linspace(min_decay, max_decay, D_HY, dtype=f32)
    decay = jnp.exp(-t * jnp.abs(deltas))
    h = h * decay[:, None, None, :]
    h_fwd, h_bwd = h[:, 0], h[:, 1]
    k = jnp.concatenate([h_fwd, jnp.zeros((1, N_FILT, D_HY), f32), h_bwd[:0:-1]], axis=0)
    return jnp.fft.rfft(k, axis=0)


def fft_conv(u, kf, bias):
    L = u.shape[1]
    uf32 = u.astype(jnp.float32)
    uf = jnp.fft.rfft(uf32, n=2 * L, axis=1)
    y = jnp.fft.irfft(uf * kf[None], n=2 * L, axis=1)[:, :L]
    return (y + uf32 * bias.astype(jnp.float32)).astype(u.dtype)


def hyena(u_proj, conv_w, conv_b, w1, b1, freq, w2, b2, w3, hy_bias):
    L = u_proj.shape[1]
    u = short_conv(u_proj, conv_w, conv_b)
    x1, x2, v = jnp.split(u, 3, axis=-1)
    kf = hyena_filters(L, w1, b1, freq, w2, b2, w3)
    z = fft_conv(v, kf[:, 0], hy_bias[0]) * x1
    z = fft_conv(z, kf[:, 1], hy_bias[1]) * x2
    return z


def rope(x, cos, sin):
    x1, x2 = jnp.split(x, 2, axis=-1)
    return jnp.concatenate([x1 * cos - x2 * sin, x1 * sin + x2 * cos], axis=-1)


def mla(c_q, c_kv, k_r, q_norm, w_uq, kv_norm, w_ukv):
    B, L, _ = c_q.shape
    q = (rmsnorm(c_q, q_norm) @ w_uq).reshape(B, L, N_HEADS, NOPE_DIM + ROPE_DIM)
    kv = (rmsnorm(c_kv, kv_norm) @ w_ukv).reshape(B, L, N_HEADS, NOPE_DIM + V_DIM)
    q_n, q_r = q[..., :NOPE_DIM], q[..., NOPE_DIM:]
    k_n, v = kv[..., :NOPE_DIM], kv[..., NOPE_DIM:]
    inv_freq = 1.0 / (ROPE_THETA ** (jnp.arange(0, ROPE_DIM, 2, dtype=jnp.float32) / ROPE_DIM))
    ang = jnp.arange(L, dtype=jnp.float32)[:, None] * inv_freq[None, :]
    cos = jnp.cos(ang).astype(q.dtype)
    sin = jnp.sin(ang).astype(q.dtype)
    q_r = rope(q_r, cos[:, None, :], sin[:, None, :])
    k_r = rope(k_r, cos, sin)
    scale = (NOPE_DIM + ROPE_DIM) ** -0.5
    nb = L // Q_BLOCK
    qn_b = q_n.reshape(B, nb, Q_BLOCK, N_HEADS, NOPE_DIM).transpose(1, 0, 2, 3, 4)
    qr_b = q_r.reshape(B, nb, Q_BLOCK, N_HEADS, ROPE_DIM).transpose(1, 0, 2, 3, 4)

    def attend(blk):
        qn, qr = blk
        s = (jnp.einsum('bqhd,bkhd->bhqk', qn, k_n, preferred_element_type=jnp.float32)
             + jnp.einsum('bqhr,bkr->bhqk', qr, k_r, preferred_element_type=jnp.float32))
        p = jax.nn.softmax(s * scale, axis=-1)
        return jnp.einsum('bhqk,bkhd->bqhd', p.astype(v.dtype), v)

    o = lax.map(attend, (qn_b, qr_b))
    return o.transpose(1, 0, 2, 3, 4).reshape(B, L, N_HEADS * V_DIM)


def pool_mixer(u, pool_w, pool_scale):
    B, L, _ = u.shape
    uf = u.astype(jnp.float32)
    cs = jnp.pad(jnp.cumsum(uf, axis=1), ((0, 0), (1, 0), (0, 0)))
    pos = jnp.arange(L, dtype=jnp.int32)
    outs = []
    for g, w in enumerate(POOL_WINDOWS):
        sl = slice(g * POOL_GRP, (g + 1) * POOL_GRP)
        csg = cs[..., sl]
        lo = jnp.clip(pos - w // 2, 0, L)
        hi = jnp.clip(pos + w // 2, 0, L)
        mean = (jnp.take(csg, hi, axis=1) - jnp.take(csg, lo, axis=1)) / (hi - lo).astype(jnp.float32)[None, :, None]
        d = (mean - uf[..., sl]).astype(u.dtype)
        outs.append(d @ pool_w[g])
    return jnp.concatenate(outs, axis=-1) * pool_scale


def trunk(x, mix_norm, w_in, hy_conv_w, hy_conv_b, hf_w1, hf_b1, hf_freq, hf_w2, hf_b2, hf_w3, hy_bias,
          q_norm, w_uq, kv_norm, w_ukv, w_out, pool_w, pool_scale, mlp_norm, mlp_w1, mlp_w2, final_norm):
    for i in range(DEPTH):
        h = rmsnorm(x, mix_norm[i])
        if i % 2 == 0:
            e = i // 2
            p = h @ w_in[e]
            u_hy = p[..., :HY_COLS]
            c_q = p[..., HY_COLS:HY_COLS + Q_LORA]
            c_kv = p[..., HY_COLS + Q_LORA:HY_COLS + Q_LORA + KV_LORA]
            k_r = p[..., IN_COLS - ROPE_DIM:]
            y_hy = hyena(u_hy, hy_conv_w[e], hy_conv_b[e], hf_w1[e], hf_b1[e], hf_freq[e],
                         hf_w2[e], hf_b2[e], hf_w3[e], hy_bias[e])
            y_att = mla(c_q, c_kv, k_r, q_norm[e], w_uq[e], kv_norm[e], w_ukv[e])
            x = x + jnp.concatenate([y_hy, y_att], axis=-1) @ w_out[e]
        else:
            o = i // 2
            x = x + pool_mixer(h, pool_w[o], pool_scale[o])
        h = rmsnorm(x, mlp_norm[i])
        x = x + jnp.square(jax.nn.relu(h @ mlp_w1[i])) @ mlp_w2[i]
    return rmsnorm(x, final_norm)


def setup_inputs(seed: int = 0) -> dict:
    key = jax.random.key(seed)
    ks = jax.random.split(key, 24)

    def nrm(k, shape, s):
        return jax.random.normal(k, shape, jnp.float32) * s

    def gain(k, shape):
        return 1.0 + 0.1 * jax.random.normal(k, shape, jnp.float32)

    ne, no = N_EVEN, N_ODD
    return {
        'x_prompt': nrm(ks[0], (BATCH, SEQ, D_MODEL), 1.0),
        'x_sample': nrm(ks[1], (DEC_BATCH, DEC_SEQ, D_MODEL), 1.0),
        'mix_norm': gain(ks[2], (DEPTH, D_MODEL)),
        'w_in': nrm(ks[3], (ne, D_MODEL, IN_COLS), D_MODEL ** -0.5),
        'hy_conv_w': nrm(ks[4], (ne, SHORT_K, HY_COLS), SHORT_K ** -0.5),
        'hy_conv_b': nrm(ks[5], (ne, HY_COLS), 0.02),
        'hf_w1': nrm(ks[6], (ne, EMB_DIM, FILT_HID), EMB_DIM ** -0.5),
        'hf_b1': nrm(ks[7], (ne, FILT_HID), 0.1),
        'hf_freq': gain(ks[8], (ne, FILT_HID)),
        'hf_w2': nrm(ks[9], (ne, FILT_HID, FILT_HID), FILT_HID ** -0.5),
        'hf_b2': nrm(ks[10], (ne, FILT_HID), 0.1),
        'hf_w3': nrm(ks[11], (ne, FILT_HID, 2 * N_FILT * D_HY), FILT_TAP_SCALE * FILT_HID ** -0.5),
        'hy_bias': nrm(ks[12], (ne, N_FILT, D_HY), 0.3),
        'q_norm': gain(ks[13], (ne, Q_LORA)),
        'w_uq': nrm(ks[14], (ne, Q_LORA, N_HEADS * (NOPE_DIM + ROPE_DIM)), Q_LORA ** -0.5),
        'kv_norm': gain(ks[15], (ne, KV_LORA)),
        'w_ukv': nrm(ks[16], (ne, KV_LORA, N_HEADS * (NOPE_DIM + V_DIM)), KV_LORA ** -0.5),
        'w_out': nrm(ks[17], (ne, MIX_WIDTH, D_MODEL), MIX_WIDTH ** -0.5),
        'pool_w': nrm(ks[18], (no, N_POOL_GROUPS, POOL_GRP, POOL_GRP), POOL_GRP ** -0.5),
        'pool_scale': gain(ks[19], (no, D_MODEL)),
        'mlp_norm': gain(ks[20], (DEPTH, D_MODEL)),
        'mlp_w1': nrm(ks[21], (DEPTH, D_MODEL, D_FF), D_MODEL ** -0.5),
        'mlp_w2': nrm(ks[22], (DEPTH, D_FF, D_MODEL), D_FF ** -0.5),
        'final_norm': gain(ks[23], (D_MODEL,)),
    }


def reference(x_prompt, x_sample, mix_norm, w_in, hy_conv_w, hy_conv_b, hf_w1, hf_b1, hf_freq, hf_w2, hf_b2,
              hf_w3, hy_bias, q_norm, w_uq, kv_norm, w_ukv, w_out, pool_w, pool_scale, mlp_norm, mlp_w1,
              mlp_w2, final_norm):
    weights = (mix_norm, w_in, hy_conv_w, hy_conv_b, hf_w1, hf_b1, hf_freq, hf_w2, hf_b2, hf_w3, hy_bias,
               q_norm, w_uq, kv_norm, w_ukv, w_out, pool_w, pool_scale, mlp_norm, mlp_w1, mlp_w2, final_norm)
    y_prompt = trunk(x_prompt, *weights)
    y_sample = trunk(x_sample, *weights)
    return (y_prompt, y_sample)
```

```cpp
#include <hip/hip_runtime.h>
#include <hip/hip_cooperative_groups.h>
#include <cstdio>
#include <cstring>
#include <cstdint>
namespace cg = cooperative_groups;

#ifndef MULTI_LAUNCH
#define MULTI_LAUNCH 0
#endif

typedef unsigned short u16;
typedef __attribute__((ext_vector_type(8))) short bf16x8;
typedef __attribute__((ext_vector_type(4))) short s16x4;
typedef __attribute__((ext_vector_type(4))) float f32x4;
typedef __attribute__((ext_vector_type(4))) unsigned u32x4;

constexpr int NT = 81920;
constexpr int TPR = 65536;
constexpr float EPS = 1e-6f;
constexpr size_t MiB = 1048576;

constexpr size_t OFF_W = 0;
constexpr size_t WIN_O = 0;
constexpr size_t WUQ_O = WIN_O + 2ull * 2304 * 1024;
constexpr size_t WUKV_O = WUQ_O + 2ull * 768 * 384;
constexpr size_t WOUT_O = WUKV_O + 2ull * 1024 * 256;
constexpr size_t WPOOL_O = WOUT_O + 2ull * 1024 * 1024;
constexpr size_t WM1_O = WPOOL_O + 8ull * 256 * 256;
constexpr size_t WM2_O = WM1_O + 4ull * 4096 * 1024;
constexpr size_t W_END = WM2_O + 4ull * 4096 * 1024;
static_assert(W_END * 2 <= 88 * MiB, "weights region");
constexpr size_t OFF_SMALL = 88 * MiB;
constexpr size_t SS_O = 0;
constexpr size_t SSQ_O = SS_O + 9ull * NT * 4;
constexpr size_t SSKV_O = SSQ_O + 2ull * NT * 4;
constexpr size_t ROPEC_O = SSKV_O + 2ull * NT * 4;
constexpr size_t ROPES_O = ROPEC_O + 8192ull * 16 * 4;
constexpr size_t H2_O = ROPES_O + 8192ull * 16 * 4;
constexpr size_t SMALL_END = H2_O + 12288ull * 64 * 4;
static_assert(SMALL_END <= 10 * MiB, "small region");
constexpr size_t OFF_XB = 98 * MiB;
constexpr size_t OFF_Q = 98 * MiB;
constexpr size_t OFF_K = 218 * MiB;
constexpr size_t OFF_KR = 298 * MiB;
constexpr size_t OFF_UT = 303 * MiB;
constexpr size_t OFF_D = 303 * MiB;
constexpr size_t OFF_VT = 543 * MiB;
constexpr size_t OFF_MIX = 623 * MiB;
constexpr size_t OFF_PQ = 623 * MiB;
constexpr size_t OFF_KF = 783 * MiB;
constexpr size_t OFF_YST = 975 * MiB;
constexpr size_t OFF_HID = 258 * MiB;
constexpr size_t OFF_PARTA = 1007 * MiB;
constexpr size_t OFF_PARTB = OFF_PARTA + (size_t)NT * 64;
constexpr size_t OFF_PQS = OFF_PARTB + (size_t)NT * 64;
constexpr size_t OFF_PKVS = OFF_PQS + (size_t)NT * 32;
constexpr size_t OFF_BAR = 1021 * MiB;
constexpr size_t WS_NEED = 1022 * MiB;
static_assert(OFF_PKVS + (size_t)NT * 16 <= WS_NEED, "ws");
constexpr int MAX_GRID = 512;

constexpr int SMEM_BYTES = 67584;
#define PADI(i) ((i) + ((i) >> 5))

struct ConvTask { const float* src; u16* dst; const float* gk; const float* gn; int K, N, Npad, perm, tile0, pad; };

struct Params {
  const float *x_prompt, *x_sample, *mix_norm, *w_in, *hy_conv_w, *hy_conv_b, *hf_w1, *hf_b1, *hf_freq, *hf_w2,
      *hf_b2, *hf_w3, *hy_bias, *q_norm, *w_uq, *kv_norm, *w_ukv, *w_out, *pool_w, *pool_scale, *mlp_norm, *mlp_w1,
      *mlp_w2, *final_norm;
  float* out;
  char* ws;
  ConvTask tasks[24];
  int ntasks, total_conv_tiles;
};

typedef __bf16 hwbf2 __attribute__((ext_vector_type(2)));
typedef float hwf2 __attribute__((ext_vector_type(2)));
__device__ __forceinline__ unsigned pack2(float a, float b) {
  const hwf2 v = {a, b};
  return __builtin_bit_cast(unsigned, __builtin_convertvector(v, hwbf2));
}
__device__ __forceinline__ u16 f2bf(float f) { return (u16)(pack2(f, 0.f) & 0xffffu); }
__device__ __forceinline__ float bf2f(u16 h) { return __uint_as_float(((unsigned)h) << 16); }
__device__ __forceinline__ float2 cmul(float2 a, float2 b) { return make_float2(a.x * b.x - a.y * b.y, a.x * b.y + a.y * b.x); }
__device__ __forceinline__ float2 cmulc(float2 a, float2 b) { return make_float2(a.x * b.x + a.y * b.y, a.y * b.x - a.x * b.y); }
__device__ __forceinline__ float2 twid(float rev) { return make_float2(__builtin_amdgcn_cosf(rev), -__builtin_amdgcn_sinf(rev)); }
__device__ __forceinline__ float sin_acc(float x) {
  double r = (double)x * 0.15915494309189533577;
  r -= floor(r);
  return __builtin_amdgcn_sinf((float)r);
}
__device__ __forceinline__ float cos_acc(float x) {
  double r = (double)x * 0.15915494309189533577;
  r -= floor(r);
  return __builtin_amdgcn_cosf((float)r);
}
__device__ __forceinline__ int ltid() { int t = threadIdx.x; asm volatile("" : "+v"(t)); return t; }
__device__ __forceinline__ char* lws(char* w) { asm volatile("" : "+s"(w)); return w; }
__device__ __forceinline__ float2 ld_l2(const float2* q) {
  const unsigned long long v = __hip_atomic_load((const unsigned long long*)q, __ATOMIC_RELAXED, __HIP_MEMORY_SCOPE_AGENT);
  return make_float2(__uint_as_float((unsigned)v), __uint_as_float((unsigned)(v >> 32)));
}
__device__ __forceinline__ u32x4 gload128(const void* q) {
  u32x4 v;
  asm volatile("global_load_dwordx4 %0, %1, off" : "=&v"(v) : "v"(q) : "memory");
  return v;
}
__device__ __forceinline__ void vm_wait0() { asm volatile("s_waitcnt vmcnt(0)" ::: "memory"); }
__device__ __forceinline__ int seq_pos(int row) { return row < TPR ? (row & 8191) : (row & 4095); }
__device__ __forceinline__ size_t ut_index(int row, int col) {
  if (row < TPR) { int b = row >> 13, t = row & 8191; return (((size_t)(b * 1536 + col)) << 13) + t; }
  int r = row - TPR; int b = r >> 12, t = r & 4095;
  return (size_t)TPR * 1536 + (((size_t)(b * 1536 + col)) << 12) + t;
}
__device__ __forceinline__ size_t vt_index(int row, int h, int d) {
  if (row < TPR) { int b = row >> 13, t = row & 8191; return (((size_t)((b * 8 + h) * 64 + d)) << 13) + t; }
  int r = row - TPR; int b = r >> 12, t = r & 4095;
  return (size_t)TPR * 512 + (((size_t)((b * 8 + h) * 64 + d)) << 12) + t;
}
__device__ __forceinline__ float row_rs16(const float* part, int row) {
  float s = 0.f;
#pragma unroll
  for (int i = 0; i < 8; ++i) s += part[(size_t)i * NT + row];
  return rsqrtf(s * (1.f / 1024.f) + EPS);
}
__device__ __forceinline__ float red16(float v) {
  v += __shfl_xor(v, 1); v += __shfl_xor(v, 2); v += __shfl_xor(v, 4); v += __shfl_xor(v, 8);
  return v;
}

#define G_LOAD(RA, RB, KT)                                                              \
  {                                                                                     \
    const int kc_ = ((KT) < nk) ? (KT) : (nk - 1);                                      \
    _Pragma("unroll") for (int i = 0; i < 4; ++i) {                                     \
      RA[i] = gload128(ap + (size_t)(32 * i) * lda + kc_ * 64);                         \
      RB[i] = gload128(bp + (size_t)(32 * i) * ldb + kc_ * 64);                         \
    }                                                                                   \
  }
#define G_STORE(RA, RB, BUF)                                                            \
  {                                                                                     \
    char* da_ = smem + (BUF) * 32768;                                                   \
    _Pragma("unroll") for (int i = 0; i < 4; ++i) {                                     \
      *(u32x4*)(da_ + soff + i * 4096) = RA[i];                                         \
      *(u32x4*)(da_ + 16384 + soff + i * 4096) = RB[i];                                 \
    }                                                                                   \
  }
#define G_COMPUTE(BUF)                                                                  \
  {                                                                                     \
    const char* sa = smem + (BUF) * 32768;                                              \
    const char* sb = sa + 16384;                                                        \
    _Pragma("unroll") for (int ks = 0; ks < 2; ++ks) {                                  \
      bf16x8 af[4], bfr[4];                                                             \
      const int coff = (((ks * 4 + g) ^ sw) << 4);                                      \
      _Pragma("unroll") for (int mi = 0; mi < 4; ++mi)                                  \
        af[mi] = *(const bf16x8*)(sa + (wr * 64 + mi * 16 + l15) * 128 + coff);         \
      _Pragma("unroll") for (int ni = 0; ni < 4; ++ni)                                  \
        bfr[ni] = *(const bf16x8*)(sb + (wc * 64 + ni * 16 + l15) * 128 + coff);        \
      __builtin_amdgcn_s_setprio(1);                                                    \
      _Pragma("unroll") for (int mi = 0; mi < 4; ++mi)                                  \
        _Pragma("unroll") for (int ni = 0; ni < 4; ++ni)                                \
          acc[mi][ni] = __builtin_amdgcn_mfma_f32_16x16x32_bf16(af[mi], bfr[ni], acc[mi][ni], 0, 0, 0); \
      __builtin_amdgcn_s_setprio(0);                                                    \
    }                                                                                   \
  }
__device__ __forceinline__ void vm_wait8() { asm volatile("s_waitcnt vmcnt(8)" ::: "memory"); }

__device__ __forceinline__ void gemm_core(const u16* __restrict__ A, int lda, const u16* __restrict__ B, int ldb, int K,
                                          char* smem, f32x4 (&acc)[4][4]) {
  const int tid = ltid(), lane = tid & 63, wave = tid >> 6, wr = wave >> 1, wc = wave & 1;
  const int lrow = tid >> 3, lch = tid & 7;
  const int l15 = lane & 15, g = lane >> 4;
  const u16* ap = A + (size_t)lrow * lda + lch * 8;
  const u16* bp = B + (size_t)lrow * ldb + lch * 8;
  const int soff = lrow * 128 + ((lch ^ ((lrow >> 1) & 7)) << 4);
  const int sw = (l15 >> 1) & 7;
  const int nk = K >> 6;
  u32x4 ra0[4], rb0[4], ra1[4], rb1[4];
  G_LOAD(ra0, rb0, 0);
  G_LOAD(ra1, rb1, 1);
#pragma unroll
  for (int mi = 0; mi < 4; ++mi)
#pragma unroll
    for (int ni = 0; ni < 4; ++ni) acc[mi][ni] = f32x4{0.f, 0.f, 0.f, 0.f};
  vm_wait8();
  G_STORE(ra0, rb0, 0);
  __syncthreads();
  for (int kt = 0; kt < nk; kt += 2) {
    G_LOAD(ra0, rb0, kt + 2);
    __builtin_amdgcn_sched_barrier(0);
    G_COMPUTE(0);
    __builtin_amdgcn_sched_barrier(0);
    vm_wait8();
    G_STORE(ra1, rb1, 1);
    __syncthreads();
    G_LOAD(ra1, rb1, kt + 3);
    __builtin_amdgcn_sched_barrier(0);
    G_COMPUTE(1);
    __builtin_amdgcn_sched_barrier(0);
    vm_wait8();
    G_STORE(ra0, rb0, 0);
    __syncthreads();
  }
  vm_wait0();
#pragma unroll
  for (int i = 0; i < 4; ++i) asm volatile("" :: "v"(ra1[i]), "v"(rb1[i]));
}

#define EPI_COORDS                                                                     \
  const int tid_e = ltid(); const int lane = tid_e & 63, wave = tid_e >> 6, wr = wave >> 1, wc = wave & 1; \
  const int l15 = lane & 15, g = lane >> 4;                                             \
  (void)wr; (void)wc; (void)l15; (void)g;

__device__ __forceinline__ void store_rows_bf16(const u16* st, int ldst, u16* dst, size_t ldd, int tid) {
#pragma unroll
  for (int i = 0; i < 8; ++i) {
    const int c = tid + 256 * i, rl = c >> 4, cc = c & 15;
    *(uint4*)(dst + (size_t)rl * ldd + cc * 8) = *(const uint4*)(st + rl * ldst + cc * 8);
  }
}

__device__ void tile_win(const Params& p, int e, int tile, char* smem) {
  const int mt = tile / 18, nt = tile % 18;
  const int m0 = mt * 128, n0 = nt * 128;
  const u16* A = (const u16*)(p.ws + OFF_XB) + (size_t)m0 * 1024;
  const u16* B = (const u16*)(p.ws + OFF_W) + WIN_O + (size_t)e * 2304 * 1024 + (size_t)n0 * 1024;
  f32x4 acc[4][4];
  gemm_core(A, 1024, B, 1024, 1024, smem, acc);
  EPI_COORDS
  const float* RSv = (const float*)(p.ws + OFF_SMALL + SS_O);
  float* pqs = (float*)(p.ws + OFF_PQS);
  float* pkvs = (float*)(p.ws + OFF_PKVS);
  u16* st = (u16*)smem;
  const int colbase = n0 + wc * 64;
#pragma unroll
  for (int mi = 0; mi < 4; ++mi) {
    const int rl0 = wr * 64 + mi * 16 + g * 4;
    const int r0 = m0 + rl0;
    float rs[4];
#pragma unroll
    for (int j = 0; j < 4; ++j) rs[j] = RSv[r0 + j];
    if (nt < 12) {
#pragma unroll
      for (int ni = 0; ni < 4; ++ni) {
        uint2 pk;
        pk.x = pack2(acc[mi][ni][0] * rs[0], acc[mi][ni][1] * rs[1]);
        pk.y = pack2(acc[mi][ni][2] * rs[2], acc[mi][ni][3] * rs[3]);
        *(uint2*)(st + (wc * 64 + ni * 16 + l15) * 136 + rl0) = pk;
      }
    } else {
      float sq[4] = {0.f, 0.f, 0.f, 0.f};
#pragma unroll
      for (int ni = 0; ni < 4; ++ni)
#pragma unroll
        for (int j = 0; j < 4; ++j) {
          const float v = acc[mi][ni][j] * rs[j];
          sq[j] += v * v;
          st[(rl0 + j) * 136 + wc * 64 + ni * 16 + l15] = f2bf(v);
        }
      if (colbase < 2176) {
#pragma unroll
        for (int j = 0; j < 4; ++j) {
          float sm_ = red16(sq[j]);
          if (l15 == 0) {
            if (colbase < 1920) pqs[((size_t)(nt - 12) * NT + (r0 + j)) * 2 + wc] = sm_;
            else pkvs[((size_t)(nt - 15) * NT + (r0 + j)) * 2 + wc] = sm_;
          }
        }
      }
    }
  }
  __syncthreads();
  if (nt < 12) {
    u16* Ut = (u16*)(p.ws + OFF_UT);
#pragma unroll
    for (int i = 0; i < 8; ++i) {
      const int c = tid_e + 256 * i, cl = c >> 4, rc = c & 15;
      *(uint4*)(Ut + ut_index(m0 + rc * 8, n0 + cl)) = *(const uint4*)(st + cl * 136 + rc * 8);
    }
  } else {
    store_rows_bf16(st, 136, (u16*)(p.ws + OFF_PQ) + (size_t)m0 * 768 + (n0 - 1536), 768, tid_e);
  }
  __syncthreads();
}

__device__ void tile_uq(const Params& p, int e, int tile, char* smem) {
  const int mt = tile / 6, nt = tile % 6;
  const int m0 = mt * 128, n0 = nt * 128;
  const u16* A = (const u16*)(p.ws + OFF_PQ) + (size_t)m0 * 768;
  const u16* B = (const u16*)(p.ws + OFF_W) + WUQ_O + (size_t)e * 768 * 384 + (size_t)n0 * 384;
  f32x4 acc[4][4];
  gemm_core(A, 768, B, 384, 384, smem, acc);
  EPI_COORDS
  const float* pqs = (const float*)(p.ws + OFF_PQS);
  const float* rc = (const float*)(p.ws + OFF_SMALL + ROPEC_O);
  const float* rsn = (const float*)(p.ws + OFF_SMALL + ROPES_O);
  u16* st = (u16*)smem;
  const float qscale = 0.10206207261596577f * 1.4426950408889634f;
#pragma unroll
  for (int mi = 0; mi < 4; ++mi) {
    const int rl0 = wr * 64 + mi * 16 + g * 4;
#pragma unroll
    for (int j = 0; j < 4; ++j) {
      const int rl = rl0 + j, row = m0 + rl;
      const float2 qa = *(const float2*)(pqs + (size_t)row * 2), qb2 = *(const float2*)(pqs + ((size_t)NT + row) * 2), qc = *(const float2*)(pqs + ((size_t)2 * NT + row) * 2);
      const float rs = rsqrtf((((qa.x + qa.y) + (qb2.x + qb2.y)) + (qc.x + qc.y)) * (1.f / 384.f) + EPS) * qscale;
      if (nt < 4) {
#pragma unroll
        for (int ni = 0; ni < 4; ++ni) st[rl * 136 + wc * 64 + ni * 16 + l15] = f2bf(acc[mi][ni][j] * rs);
      } else {
        const int pos = seq_pos(row);
        const float c = rc[pos * 16 + l15], sn = rsn[pos * 16 + l15];
#pragma unroll
        for (int pp = 0; pp < 2; ++pp) {
          const float x1 = acc[mi][2 * pp][j] * rs, x2 = acc[mi][2 * pp + 1][j] * rs;
          st[rl * 136 + (wc * 2 + pp) * 32 + l15] = f2bf(x1 * c - x2 * sn);
          st[rl * 136 + (wc * 2 + pp) * 32 + 16 + l15] = f2bf(x1 * sn + x2 * c);
        }
      }
    }
  }
  __syncthreads();
  u16* Qn = (u16*)(p.ws + OFF_Q);
  u16* Qr = Qn + (size_t)NT * 512;
  if (nt < 4) store_rows_bf16(st, 136, Qn + (size_t)m0 * 512 + n0, 512, tid_e);
  else store_rows_bf16(st, 136, Qr + (size_t)m0 * 256 + (nt - 4) * 128, 256, tid_e);
  __syncthreads();
}

__device__ void tile_ukv(const Params& p, int e, int tile, char* smem) {
  const int mt = tile >> 3, h = tile & 7;
  const int m0 = mt * 128, n0 = h * 128;
  const u16* A = (const u16*)(p.ws + OFF_PQ) + (size_t)m0 * 768 + 384;
  const u16* B = (const u16*)(p.ws + OFF_W) + WUKV_O + (size_t)e * 1024 * 256 + (size_t)n0 * 256;
  f32x4 acc[4][4];
  gemm_core(A, 768, B, 256, 256, smem, acc);
  EPI_COORDS
  const float* pkvs = (const float*)(p.ws + OFF_PKVS);
  u16* stK = (u16*)smem;
  u16* stV = (u16*)(smem + 18432);
#pragma unroll
  for (int mi = 0; mi < 4; ++mi) {
    const int rl0 = wr * 64 + mi * 16 + g * 4;
    const int r0 = m0 + rl0;
    float rs[4];
#pragma unroll
    for (int j = 0; j < 4; ++j) { const float2 ka = *(const float2*)(pkvs + (size_t)(r0 + j) * 2), kb2 = *(const float2*)(pkvs + ((size_t)NT + r0 + j) * 2); rs[j] = rsqrtf(((ka.x + ka.y) + (kb2.x + kb2.y)) * (1.f / 256.f) + EPS); }
    if (wc == 0) {
#pragma unroll
      for (int ni = 0; ni < 4; ++ni)
#pragma unroll
        for (int j = 0; j < 4; ++j) stK[(rl0 + j) * 72 + ni * 16 + l15] = f2bf(acc[mi][ni][j] * rs[j]);
    } else {
#pragma unroll
      for (int ni = 0; ni < 4; ++ni) {
        uint2 pk;
        pk.x = pack2(acc[mi][ni][0] * rs[0], acc[mi][ni][1] * rs[1]);
        pk.y = pack2(acc[mi][ni][2] * rs[2], acc[mi][ni][3] * rs[3]);
        *(uint2*)(stV + (ni * 16 + l15) * 136 + rl0) = pk;
      }
    }
  }
  __syncthreads();
  u16* Kb = (u16*)(p.ws + OFF_K);
  u16* Vt = (u16*)(p.ws + OFF_VT);
#pragma unroll
  for (int i = 0; i < 4; ++i) {
    const int c = tid_e + 256 * i;
    { const int rl = c >> 3, cc = c & 7;
      *(uint4*)(Kb + (size_t)(m0 + rl) * 512 + h * 64 + cc * 8) = *(const uint4*)(stK + rl * 72 + cc * 8); }
    { const int d = c >> 4, rcx = c & 15;
      *(uint4*)(Vt + vt_index(m0 + rcx * 8, h, d)) = *(const uint4*)(stV + d * 136 + rcx * 8); }
  }
  __syncthreads();
}

__device__ __forceinline__ void epi_res(const Params& p, f32x4 (&acc)[4][4], int m0, int n0, const float* srcp,
                                        const float* srcs, float* ssn, char* smem) {
  EPI_COORDS
  float* st = (float*)smem;
#pragma unroll
  for (int mi = 0; mi < 4; ++mi)
#pragma unroll
    for (int ni = 0; ni < 4; ++ni)
#pragma unroll
      for (int j = 0; j < 4; ++j) st[(wr * 64 + mi * 16 + g * 4 + j) * 132 + wc * 64 + ni * 16 + l15] = acc[mi][ni][j];
  __syncthreads();
  u16* xb = (u16*)(p.ws + OFF_XB);
  const int cc = tid_e & 31, r8 = tid_e >> 5;
#pragma unroll 4
  for (int i = 0; i < 16; ++i) {
    const int rl = i * 8 + r8;
    const int row = m0 + rl;
    const float4 d = *(const float4*)(st + rl * 132 + cc * 4);
    const float* xin = (row < TPR) ? (srcp + (size_t)row * 1024) : (srcs + (size_t)(row - TPR) * 1024);
    const float4 x = *(const float4*)(xin + n0 + cc * 4);
    float4 xn; xn.x = x.x + d.x; xn.y = x.y + d.y; xn.z = x.z + d.z; xn.w = x.w + d.w;
    *(float4*)(p.out + (size_t)row * 1024 + n0 + cc * 4) = xn;
    uint2 pk; pk.x = pack2(xn.x, xn.y); pk.y = pack2(xn.z, xn.w);
    *(uint2*)(xb + (size_t)row * 1024 + n0 + cc * 4) = pk;
    float sq = xn.x * xn.x + xn.y * xn.y + xn.z * xn.z + xn.w * xn.w;
    sq += __shfl_xor(sq, 1); sq += __shfl_xor(sq, 2); sq += __shfl_xor(sq, 4); sq += __shfl_xor(sq, 8); sq += __shfl_xor(sq, 16);
    if (cc == 0) ssn[(size_t)(n0 >> 7) * NT + row] = sq;
  }
  __syncthreads();
}

__device__ void tile_wout(const Params& p, int layer, int tile, char* smem) {
  const int e = layer >> 1;
  const int mt = tile >> 3, nt = tile & 7;
  const int m0 = mt * 128, n0 = nt * 128;
  const u16* A = (const u16*)(p.ws + OFF_MIX) + (size_t)m0 * 1024;
  const u16* B = (const u16*)(p.ws + OFF_W) + WOUT_O + (size_t)e * 1024 * 1024 + (size_t)n0 * 1024;
  f32x4 acc[4][4];
  gemm_core(A, 1024, B, 1024, 1024, smem, acc);
  const float* sp = (layer == 0) ? p.x_prompt : p.out;
  const float* ssrc = (layer == 0) ? p.x_sample : (p.out + (size_t)TPR * 1024);
  epi_res(p, acc, m0, n0, sp, ssrc, (float*)(p.ws + OFF_PARTA), smem);
}

__device__ void tile_pool(const Params& p, int layer, int tile, char* smem) {
  const int o = layer >> 1;
  const int mt = tile >> 3, nt = tile & 7, gi = nt >> 1;
  const int m0 = mt * 128, n0 = nt * 128;
  const u16* A = (const u16*)(p.ws + OFF_D) + (size_t)m0 * 1024 + gi * 256;
  const u16* B = (const u16*)(p.ws + OFF_W) + WPOOL_O + (size_t)(o * 4 + gi) * 65536 + (size_t)(nt & 1) * 128 * 256;
  f32x4 acc[4][4];
  gemm_core(A, 1024, B, 256, 256, smem, acc);
  epi_res(p, acc, m0, n0, p.out, p.out + (size_t)TPR * 1024, (float*)(p.ws + OFF_PARTA), smem);
}

__device__ void tile_mlp1(const Params& p, int layer, int tile, char* smem) {
  (void)layer;
  const int mt = tile >> 5, nt = tile & 31;
  const int m0 = mt * 128, n0 = nt * 128;
  const u16* A = (const u16*)(p.ws + OFF_XB) + (size_t)m0 * 1024;
  const u16* B = (const u16*)(p.ws + OFF_W) + WM1_O + (size_t)layer * 4096 * 1024 + (size_t)n0 * 1024;
  f32x4 acc[4][4];
  gemm_core(A, 1024, B, 1024, 1024, smem, acc);
  EPI_COORDS
  const float* RSv = (const float*)(p.ws + OFF_SMALL + SS_O);
  u16* st = (u16*)smem;
#pragma unroll
  for (int mi = 0; mi < 4; ++mi) {
    const int rl0 = wr * 64 + mi * 16 + g * 4;
#pragma unroll
    for (int j = 0; j < 4; ++j) {
      const float rs = RSv[m0 + rl0 + j];
#pragma unroll
      for (int ni = 0; ni < 4; ++ni) {
        const float v = fmaxf(acc[mi][ni][j] * rs, 0.f);
        st[(rl0 + j) * 136 + wc * 64 + ni * 16 + l15] = f2bf(v * v);
      }
    }
  }
  __syncthreads();
  u16* Hd = (u16*)(p.ws + OFF_HID);
#pragma unroll
  for (int i = 0; i < 8; ++i) {
    const int c = tid_e + 256 * i, rl = c >> 4, cc = c & 15;
    const uint4 v = *(const uint4*)(st + rl * 136 + cc * 8);
    *(uint4*)(Hd + (size_t)(m0 + rl) * 4096 + n0 + cc * 8) = v;
  }
  __syncthreads();
}

__device__ void tile_mlp2(const Params& p, int layer, int tile, char* smem) {
  const int mt = tile >> 3, nt = tile & 7;
  const int m0 = mt * 128, n0 = nt * 128;
  const u16* A = (const u16*)(p.ws + OFF_HID) + (size_t)m0 * 4096;
  const u16* B = (const u16*)(p.ws + OFF_W) + WM2_O + (size_t)layer * 4096 * 1024 + (size_t)n0 * 4096;
  f32x4 acc[4][4];
  gemm_core(A, 4096, B, 4096, 4096, smem, acc);
  epi_res(p, acc, m0, n0, p.out, p.out + (size_t)TPR * 1024, (float*)(p.ws + OFF_PARTB), smem);
}

__device__ void conv_tile(const ConvTask& t, int tile, char* smem) {
  float* sm = (float*)smem;
  const int nkt = t.K >> 6;
  const int kt = tile % nkt, nt = tile / nkt;
  const int tid = ltid();
  {
    const int nn = tid & 63, k4 = tid >> 6;
    const int np = nt * 64 + nn;
    int ns = np;
    if (t.perm) ns = (np < 512) ? ((np >> 6) * 96 + (np & 63)) : (((np - 512) >> 5) * 96 + 64 + ((np - 512) & 31));
    const float gn = (t.gn && np < t.N) ? t.gn[ns] : 1.f;
#pragma unroll
    for (int r = 0; r < 16; ++r) {
      const int kk = k4 + 4 * r;
      const int k = kt * 64 + kk;
      float v = 0.f;
      if (np < t.N) {
        v = t.src[(size_t)k * t.N + ns] * gn;
        if (t.gk) v *= t.gk[k];
      }
      sm[kk * 65 + nn] = v;
    }
  }
  __syncthreads();
  {
    const int kk = tid & 63, n4 = tid >> 6;
#pragma unroll
    for (int r = 0; r < 16; ++r) {
      const int nn = n4 + 4 * r;
      t.dst[(size_t)(nt * 64 + nn) * t.K + kt * 64 + kk] = f2bf(sm[kk * 65 + nn]);
    }
  }
  __syncthreads();
}

__device__ void phase_prep(const Params& p, char* smem) {
  int G = gridDim.x; asm volatile("" : "+s"(G));
  const int bid = blockIdx.x, tid = ltid();
  for (int tile = bid; tile < p.total_conv_tiles; tile += G) {
    int ti = 0;
    for (int i = 1; i < p.ntasks; ++i)
      if (tile >= p.tasks[i].tile0) ti = i;
    conv_tile(p.tasks[ti], tile - p.tasks[ti].tile0, smem);
  }
#ifdef ZERO_WS
  {
    uint4* z = (uint4*)(p.ws + 258 * MiB);
    const size_t n = (size_t)(1007 - 258) * MiB / 16;
    for (size_t i = (size_t)bid * 256 + tid; i < n; i += (size_t)G * 256) z[i] = make_uint4(0u, 0u, 0u, 0u);
  }
#endif
  {
    float* rc = (float*)(p.ws + OFF_SMALL + ROPEC_O);
    float* rsn = (float*)(p.ws + OFF_SMALL + ROPES_O);
    for (int i = bid * 256 + tid; i < 8192 * 16; i += G * 256) {
      const int pos = i >> 4, j = i & 15;
      const float inv_freq = 1.0f / powf(10000.f, (float)(2 * j) / 32.f);
      const float ang = (float)pos * inv_freq;
      rc[i] = cos_acc(ang);
      rsn[i] = sin_acc(ang);
    }
  }
  {
    u16* xb = (u16*)(p.ws + OFF_XB);
    float* RSw = (float*)(p.ws + OFF_SMALL + SS_O);
    const int lane = tid & 63, wave = tid >> 6;
    for (int rr = bid * 16 + wave * 4; rr < NT; rr += G * 16)
    for (int row = rr; row < rr + 4; ++row) {
      const float* xr = (row < TPR) ? (p.x_prompt + (size_t)row * 1024) : (p.x_sample + (size_t)(row - TPR) * 1024);
      float sq = 0.f;
#pragma unroll
      for (int i = 0; i < 4; ++i) {
        const float4 v = *(const float4*)(xr + i * 256 + lane * 4);
        sq += v.x * v.x + v.y * v.y + v.z * v.z + v.w * v.w;
        uint2 pk; pk.x = pack2(v.x, v.y); pk.y = pack2(v.z, v.w);
        *(uint2*)(xb + (size_t)row * 1024 + i * 256 + lane * 4) = pk;
      }
      sq += __shfl_xor(sq, 1); sq += __shfl_xor(sq, 2); sq += __shfl_xor(sq, 4);
      sq += __shfl_xor(sq, 8); sq += __shfl_xor(sq, 16); sq += __shfl_xor(sq, 32);
      if (lane == 0) RSw[row] = rsqrtf(sq * (1.f / 1024.f) + EPS);
    }
  }
}

__device__ void h2_job(const Params& p, int e, int job, char* smem) {
  float* zs = (float*)smem;
  float* h1s = zs + 4 * 36;
  const int tid = ltid(), u = tid & 63, tq = tid >> 6;
  int L, tbase; float* H2;
  if (job < 128) { L = 8192; tbase = job * 64; H2 = (float*)(p.ws + OFF_SMALL + H2_O); }
  else { L = 4096; tbase = (job - 128) * 64; H2 = (float*)(p.ws + OFF_SMALL + H2_O) + 8192 * 64; }
  const float* w1 = p.hf_w1 + (size_t)e * 33 * 64;
  const float* w2 = p.hf_w2 + (size_t)e * 64 * 64;
  const float b1 = p.hf_b1[e * 64 + u], b2 = p.hf_b2[e * 64 + u], fr = p.hf_freq[e * 64 + u];
  for (int it = 0; it < 16; ++it) {
    const int t = tbase + it * 4 + tq;
    if (u < 33) {
      float z;
      if (u == 0) z = (float)t / (float)(L - 1);
      else {
        const int j = (u - 1) & 15;
        const float band = 1e-4f + (float)j * ((15.f - 1e-4f) / 15.f);
        const float wpos = (6.283185307179586f / (float)L) * (float)t;
        const float ang = band * wpos;
        z = (u <= 16) ? cos_acc(ang) : -sin_acc(ang);
      }
      zs[tq * 36 + u] = z;
    }
    __syncthreads();
    float a = b1;
#pragma unroll
    for (int i = 0; i < 33; ++i) a += zs[tq * 36 + i] * w1[i * 64 + u];
    h1s[tq * 64 + u] = sin_acc(fr * a);
    __syncthreads();
    float a2 = b2;
#pragma unroll 8
    for (int i = 0; i < 64; ++i) a2 += h1s[tq * 64 + i] * w2[i * 64 + u];
    H2[(size_t)t * 64 + u] = sin_acc(fr * a2);
    __syncthreads();
  }
}

__device__ __forceinline__ float2 w16c(int k) {
  switch (k) {
    case 0: return make_float2(1.f, 0.f);
    case 1: return make_float2(0.9238795325112867f, -0.3826834323650898f);
    case 2: return make_float2(0.7071067811865476f, -0.7071067811865476f);
    case 3: return make_float2(0.3826834323650898f, -0.9238795325112867f);
    case 4: return make_float2(0.f, -1.f);
    case 5: return make_float2(-0.3826834323650898f, -0.9238795325112867f);
    case 6: return make_float2(-0.7071067811865476f, -0.7071067811865476f);
    default: return make_float2(-0.9238795325112867f, -0.3826834323650898f);
  }
}

template <int R, int HALF, bool INV, bool HASW>
__device__ __forceinline__ void fft_stage(float2 (&x)[R], const float2 wk) {
#pragma unroll
  for (int bs = 0; bs < R; bs += 2 * HALF) {
#pragma unroll
    for (int jj = 0; jj < HALF; ++jj) {
      const float2 c = w16c(jj * 8 / HALF);
      float2 t;
      if (HASW) t = (jj == 0) ? wk : cmul(wk, c); else t = c;
      const float2 a = x[bs + jj];
      if (!INV) {
        const float2 b = x[bs + jj + HALF];
        const float2 d = make_float2(a.x - b.x, a.y - b.y);
        x[bs + jj] = make_float2(a.x + b.x, a.y + b.y);
        x[bs + jj + HALF] = (!HASW && jj == 0) ? d : cmul(d, t);
      } else {
        const float2 b = (!HASW && jj == 0) ? x[bs + jj + HALF] : cmulc(x[bs + jj + HALF], t);
        x[bs + jj] = make_float2(a.x + b.x, a.y + b.y);
        x[bs + jj + HALF] = make_float2(a.x - b.x, a.y - b.y);
      }
    }
  }
}

template <int LOGR, int SLOG, bool INV, int LOGL>
__device__ __forceinline__ void fft_pass(float2* buf) {
  constexpr int R = 1 << LOGR, S = 1 << SLOG, L = 1 << LOGL, NB = L / R;
  constexpr bool HASW = (SLOG > 0);
  const int tid_f = ltid();
#pragma unroll 1
  for (int q = tid_f; q < NB; q += 256) {
    const int lo = q & (S - 1), hi = q >> SLOG;
    const int base = (hi << (SLOG + LOGR)) + lo;
    float2 x[R];
#pragma unroll
    for (int j = 0; j < R; ++j) x[j] = buf[PADI(base + j * S)];
    float2 w1 = make_float2(1.f, 0.f);
    if (HASW) w1 = twid((float)lo * (1.f / (float)(R * S)));
    const float2 w2 = cmul(w1, w1), w4 = cmul(w2, w2), w8 = cmul(w4, w4);
    if (R == 16) {
      if (!INV) { fft_stage<R, R / 2, INV, HASW>(x, w1); fft_stage<R, R / 4, INV, HASW>(x, w2); fft_stage<R, R / 8, INV, HASW>(x, w4); fft_stage<R, (R >= 16 ? R / 16 : 1), INV, HASW>(x, w8); }
      else { fft_stage<R, (R >= 16 ? R / 16 : 1), INV, HASW>(x, w8); fft_stage<R, R / 8, INV, HASW>(x, w4); fft_stage<R, R / 4, INV, HASW>(x, w2); fft_stage<R, R / 2, INV, HASW>(x, w1); }
    } else {
      if (!INV) { fft_stage<R, R / 2, INV, HASW>(x, w1); fft_stage<R, R / 4, INV, HASW>(x, w2); fft_stage<R, R / 8, INV, HASW>(x, w4); }
      else { fft_stage<R, R / 8, INV, HASW>(x, w4); fft_stage<R, R / 4, INV, HASW>(x, w2); fft_stage<R, R / 2, INV, HASW>(x, w1); }
    }
#pragma unroll
    for (int j = 0; j < R; ++j) buf[PADI(base + j * S)] = x[j];
  }
  __syncthreads();
}

template <int LOGL> __device__ __forceinline__ void fft_fwd(float2* buf) {
  if (LOGL == 13) {
    fft_pass<4, 9, false, LOGL>(buf); fft_pass<3, 6, false, LOGL>(buf); fft_pass<3, 3, false, LOGL>(buf); fft_pass<3, 0, false, LOGL>(buf);
  } else {
    fft_pass<3, 9, false, LOGL>(buf); fft_pass<3, 6, false, LOGL>(buf); fft_pass<3, 3, false, LOGL>(buf); fft_pass<3, 0, false, LOGL>(buf);
  }
}
template <int LOGL> __device__ __forceinline__ void fft_inv(float2* buf) {
  if (LOGL == 13) {
    fft_pass<3, 0, true, LOGL>(buf); fft_pass<3, 3, true, LOGL>(buf); fft_pass<3, 6, true, LOGL>(buf); fft_pass<4, 9, true, LOGL>(buf);
  } else {
    fft_pass<3, 0, true, LOGL>(buf); fft_pass<3, 3, true, LOGL>(buf); fft_pass<3, 6, true, LOGL>(buf); fft_pass<3, 9, true, LOGL>(buf);
  }
}

template <int LOGL> __device__ __forceinline__ void fft_fwd_head(float2* buf) {
  if (LOGL == 13) { fft_pass<4, 9, false, LOGL>(buf); fft_pass<3, 6, false, LOGL>(buf); fft_pass<3, 3, false, LOGL>(buf); }
  else { fft_pass<3, 9, false, LOGL>(buf); fft_pass<3, 6, false, LOGL>(buf); fft_pass<3, 3, false, LOGL>(buf); }
}
template <int LOGL> __device__ __forceinline__ void fft_inv_tail(float2* buf) {
  if (LOGL == 13) { fft_pass<3, 3, true, LOGL>(buf); fft_pass<3, 6, true, LOGL>(buf); fft_pass<4, 9, true, LOGL>(buf); }
  else { fft_pass<3, 3, true, LOGL>(buf); fft_pass<3, 6, true, LOGL>(buf); fft_pass<3, 9, true, LOGL>(buf); }
}
template <int LOGL> __device__ __forceinline__ void fft_mid(float2* buf, const float2* __restrict__ Kf) {
  constexpr int L = 1 << LOGL, NB = L / 8;
  const int tid_f = ltid();
#pragma unroll 1
  for (int q = tid_f; q < NB; q += 256) {
    const int base = q << 3;
    float2 x[8], k[8];
#pragma unroll
    for (int j = 0; j < 8; ++j) x[j] = buf[PADI(base) + j];
    {
      const float4 k0 = *(const float4*)(Kf + base), k1 = *(const float4*)(Kf + base + 2);
      const float4 k2 = *(const float4*)(Kf + base + 4), k3 = *(const float4*)(Kf + base + 6);
      k[0] = make_float2(k0.x, k0.y); k[1] = make_float2(k0.z, k0.w); k[2] = make_float2(k1.x, k1.y); k[3] = make_float2(k1.z, k1.w);
      k[4] = make_float2(k2.x, k2.y); k[5] = make_float2(k2.z, k2.w); k[6] = make_float2(k3.x, k3.y); k[7] = make_float2(k3.z, k3.w);
    }
    const float2 one = make_float2(1.f, 0.f);
    fft_stage<8, 4, false, false>(x, one); fft_stage<8, 2, false, false>(x, one); fft_stage<8, 1, false, false>(x, one);
#pragma unroll
    for (int j = 0; j < 8; ++j) x[j] = cmul(x[j], k[j]);
    fft_stage<8, 1, true, false>(x, one); fft_stage<8, 2, true, false>(x, one); fft_stage<8, 4, true, false>(x, one);
#pragma unroll
    for (int j = 0; j < 8; ++j) buf[PADI(base) + j] = x[j];
  }
  __syncthreads();
}

template <int LOGL> __device__ __forceinline__ float2* kf_ptr(const Params& p, int filt, int c, int half) {
  float2* base = (float2*)(p.ws + OFF_KF);
  if (LOGL == 12) base += (size_t)2 * 512 * 2 * 8192;
  return base + ((size_t)((filt * 512 + c) * 2 + half) << LOGL);
}

template <int LOGL> __device__ void filt_job(const Params& p, int e, int filt, int c, char* smem) {
  constexpr int L = 1 << LOGL, NE = L / 256;
  float2* buf = (float2*)smem;
  float* w3s = (float*)(smem + SMEM_BYTES - 512);
  const int tid = ltid();
  const float* H2 = (const float*)(p.ws + OFF_SMALL + H2_O) + (LOGL == 12 ? 8192 * 64 : 0);
  const float* w3 = p.hf_w3 + (size_t)e * 64 * 2048;
  if (tid < 128) {
    const int dir = tid >> 6, u = tid & 63;
    w3s[tid] = w3[(size_t)u * 2048 + dir * 1024 + filt * 512 + c];
  }
  __syncthreads();
  const float min_decay = -3.0701134573253945f, max_decay = -15.350567286626972f;
  const float delta = fabsf(min_decay + (max_decay - min_decay) * ((float)c / 511.f));
  {
    const int lane = tid & 63, wave = tid >> 6, rl = lane >> 2, q4 = lane & 3;
    constexpr int NIT = L / 64;
#pragma unroll 2
    for (int it = 0; it < NIT; ++it) {
      const int t = it * 64 + wave * 16 + rl;
      const float4* hr = (const float4*)(H2 + (size_t)t * 64 + q4 * 16);
      float af = 0.f, ab = 0.f;
#pragma unroll
      for (int q = 0; q < 4; ++q) {
        const float4 h = hr[q];
        const float* wf = w3s + q4 * 16 + q * 4;
        af += h.x * wf[0] + h.y * wf[1] + h.z * wf[2] + h.w * wf[3];
        ab += h.x * wf[64] + h.y * wf[65] + h.z * wf[66] + h.w * wf[67];
      }
      af += __shfl_xor(af, 1); ab += __shfl_xor(ab, 1);
      af += __shfl_xor(af, 2); ab += __shfl_xor(ab, 2);
      const float tl = (float)t / (float)(L - 1);
      const float dec = __expf(-tl * delta);
      if (it == NIT - 1) __syncthreads();
      if (q4 == 0) buf[PADI(t)] = make_float2(af * dec, ab * dec);
    }
  }
  __syncthreads();
  float2* dstE = kf_ptr<LOGL>(p, filt, c, 0);
  float2* dstO = kf_ptr<LOGL>(p, filt, c, 1);
#pragma unroll 2
  for (int i = 0; i < NE / 2; ++i) {
    const int u = tid + 256 * i;
    const int t0 = u, t1 = (u == 0) ? (L / 2) : (L - u);
    const float2 e0 = buf[PADI(t0)], e1 = buf[PADI(t1)];
    const float a0 = e0.x, b0 = (u == 0) ? 0.f : e1.y;
    const float a1 = e1.x, b1f = (u == 0) ? e1.y : e0.y;
    const float2 w0 = twid((float)t0 * (1.f / (float)(2 * L))), w1 = twid((float)t1 * (1.f / (float)(2 * L)));
    const float d0 = a0 - b0, d1 = a1 - b1f;
    dstO[t0] = make_float2(d0 * w0.x, d0 * w0.y);
    dstO[t1] = make_float2(d1 * w1.x, d1 * w1.y);
    buf[PADI(t0)] = make_float2(a0 + b0, 0.f);
    buf[PADI(t1)] = make_float2(a1 + b1f, 0.f);
  }
  __syncthreads();
  fft_fwd<LOGL>(buf);
  const float nrm = 1.f / (float)(2 * L);
#pragma unroll 4
  for (int i = 0; i < NE; ++i) { const float2 v = buf[PADI(tid + 256 * i)]; dstE[tid + 256 * i] = make_float2(v.x * nrm, v.y * nrm); }
  __syncthreads();
#pragma unroll 2
  for (int i = 0; i < NE / 2; ++i) {
    const int u = tid + 256 * i;
    const int t0 = u, t1 = (u == 0) ? (L / 2) : (L - u);
    buf[PADI(t0)] = dstO[t0];
    buf[PADI(t1)] = dstO[t1];
  }
  __syncthreads();
  fft_fwd<LOGL>(buf);
#pragma unroll 4
  for (int i = 0; i < NE; ++i) { const float2 v = buf[PADI(tid + 256 * i)]; dstO[tid + 256 * i] = make_float2(v.x * nrm, v.y * nrm); }
  __syncthreads();
}

__device__ __forceinline__ void short_conv4(const u16* u, int t, int L, float w0, float w1, float w2, float bias, float (&o)[4]) {
  const uint2 mid = *(const uint2*)(u + t);
  const int tm = (t > 0) ? t - 1 : 0, tp = (t + 4 < L) ? t + 4 : L - 1;
  const float vm = bf2f(u[tm]), vp = bf2f(u[tp]);
  const float um = (t > 0) ? vm : 0.f, up = (t + 4 < L) ? vp : 0.f;
  const float u0 = __uint_as_float(mid.x << 16), u1 = __uint_as_float(mid.x & 0xffff0000u);
  const float u2 = __uint_as_float(mid.y << 16), u3 = __uint_as_float(mid.y & 0xffff0000u);
  o[0] = w0 * um + w1 * u0 + w2 * u1 + bias;
  o[1] = w0 * u0 + w1 * u1 + w2 * u2 + bias;
  o[2] = w0 * u1 + w1 * u2 + w2 * u3 + bias;
  o[3] = w0 * u2 + w1 * u3 + w2 * up + bias;
}

struct HyCtx { u16* base; float w0, w1, w2, bs; const float2* zin; };
template <int LOGL> __device__ __forceinline__ float2* hy_zptr(u16* base, int t) {
  constexpr int L = 1 << LOGL;
  const int ch = t >> (LOGL - 2);
  u16* b = base + (((size_t)((ch & 1) * 1536 + (ch >> 1) * 1024)) << LOGL);
  return (float2*)b + (t & (L / 4 - 1));
}
__device__ __forceinline__ void ld4(const float2* q, float2 (&e)[4]) {
  const float4 a = *(const float4*)q, b = *(const float4*)(q + 2);
  e[0] = make_float2(a.x, a.y); e[1] = make_float2(a.z, a.w); e[2] = make_float2(b.x, b.y); e[3] = make_float2(b.z, b.w);
}
__device__ __forceinline__ void st4(float2* q, const float2 (&e)[4]) {
  *(float4*)q = make_float4(e[0].x, e[0].y, e[1].x, e[1].y);
  *(float4*)(q + 2) = make_float4(e[2].x, e[2].y, e[3].x, e[3].y);
}
template <int LOGL, int SRC> __device__ __forceinline__ void hy_a4(const HyCtx c, int t, float2 (&e)[4]) {
  constexpr int L = 1 << LOGL;
  if (SRC == 0) {
    const u16* va = c.base + ((size_t)1024 << LOGL);
    const u16* vb = c.base + ((size_t)(1536 + 1024) << LOGL);
    float sa[4], sb[4];
    short_conv4(va, t, L, c.w0, c.w1, c.w2, c.bs, sa);
    short_conv4(vb, t, L, c.w0, c.w1, c.w2, c.bs, sb);
#pragma unroll
    for (int k = 0; k < 4; ++k) e[k] = make_float2(sa[k], sb[k]);
  } else {
    ld4(c.zin + t, e);
  }
}

struct HyPost { const u16 *xa, *xb; float w0, w1, w2, bs, bias; };
template <int LOGL, int STASH> __device__ __forceinline__ float2* hy_stash(float2* yst, u16* base, int t) {
  return (STASH == 0) ? (yst + t) : hy_zptr<LOGL>(base, t);
}
template <int LOGL, int SRC, int STASH>
__device__ __forceinline__ void long_conv(const HyCtx c, float2* yst, const float2* KE, const float2* KO, float2* buf, const HyPost pp) {
  constexpr int L = 1 << LOGL, NQ = L / 1024;
  const int tid = ltid();
#pragma unroll 2
  for (int i = 0; i < NQ; ++i) {
    const int t = 4 * (tid + 256 * i);
    float2 a[4], ow[4];
    hy_a4<LOGL, SRC>(c, t, a);
#pragma unroll
    for (int k = 0; k < 4; ++k) {
      buf[PADI(t) + k] = a[k];
      ow[k] = cmul(a[k], twid((float)(t + k) * (1.f / (float)(2 * L))));
    }
    st4(hy_stash<LOGL, STASH>(yst, c.base, t), ow);
  }
  __syncthreads();
  fft_fwd_head<LOGL>(buf);
  fft_mid<LOGL>(buf, KE);
  fft_inv_tail<LOGL>(buf);
#pragma unroll 2
  for (int i = 0; i < NQ; ++i) {
    const int t = 4 * (tid + 256 * i);
    float2 v[4], ow[4];
#pragma unroll
    for (int k = 0; k < 4; ++k) v[k] = buf[PADI(t) + k];
    ld4(hy_stash<LOGL, STASH>(yst, c.base, t), ow);
    st4(hy_stash<LOGL, STASH>(yst, c.base, t), v);
#pragma unroll
    for (int k = 0; k < 4; ++k) buf[PADI(t) + k] = ow[k];
  }
  __syncthreads();
  fft_fwd_head<LOGL>(buf);
  fft_mid<LOGL>(buf, KO);
  fft_inv_tail<LOGL>(buf);
#pragma unroll 2
  for (int i = 0; i < NQ; ++i) {
    const int t = 4 * (tid + 256 * i);
    float2 y[4], a[4];
    float xa[4], xb_[4];
    ld4(hy_stash<LOGL, STASH>(yst, c.base, t), y);
    hy_a4<LOGL, SRC>(c, t, a);
    short_conv4(pp.xa, t, L, pp.w0, pp.w1, pp.w2, pp.bs, xa);
    short_conv4(pp.xb, t, L, pp.w0, pp.w1, pp.w2, pp.bs, xb_);
#pragma unroll
    for (int k = 0; k < 4; ++k) {
      const float2 v = cmulc(buf[PADI(t) + k], twid((float)(t + k) * (1.f / (float)(2 * L))));
      y[k] = make_float2((y[k].x + v.x + pp.bias * a[k].x) * xa[k], (y[k].y + v.y + pp.bias * a[k].y) * xb_[k]);
    }
    st4(hy_stash<LOGL, STASH>(yst, c.base, t), y);
  }
  __syncthreads();
}

template <int LOGL> __device__ void hyena_job(const Params& p, int e, int c, int b0, char* smem) {
  constexpr int L = 1 << LOGL, NQ = L / 1024;
  float2* buf = (float2*)smem;
  const int tid = ltid();
  float2* yst = (float2*)(p.ws + OFF_YST) + (size_t)blockIdx.x * 8192;
  u16* Ut = (u16*)(p.ws + OFF_UT) + (LOGL == 12 ? (size_t)TPR * 1536 : 0);
  u16* x1a = Ut + (((size_t)(b0 * 1536 + c)) << LOGL);
  u16* x1b = Ut + (((size_t)((b0 + 1) * 1536 + c)) << LOGL);
  u16* x2a = x1a + ((size_t)512 << LOGL); u16* x2b = x1b + ((size_t)512 << LOGL);
  const float* cw = p.hy_conv_w + (size_t)e * 3 * 1536;
  const float* cb = p.hy_conv_b + (size_t)e * 1536;
  const float bias0 = p.hy_bias[(size_t)e * 1024 + c], bias1 = p.hy_bias[(size_t)e * 1024 + 512 + c];
  HyCtx cx;
  cx.base = x1a; cx.zin = yst;
  cx.w0 = cw[1024 + c]; cx.w1 = cw[1536 + 1024 + c]; cx.w2 = cw[3072 + 1024 + c]; cx.bs = cb[1024 + c];
  {
    HyPost pp; pp.xa = x1a; pp.xb = x1b; pp.w0 = cw[c]; pp.w1 = cw[1536 + c]; pp.w2 = cw[3072 + c]; pp.bs = cb[c]; pp.bias = bias0;
    long_conv<LOGL, 0, 0>(cx, yst, kf_ptr<LOGL>(p, 0, c, 0), kf_ptr<LOGL>(p, 0, c, 1), buf, pp);
  }
  {
    const int col = 512 + c;
    HyPost pp; pp.xa = x2a; pp.xb = x2b; pp.w0 = cw[col]; pp.w1 = cw[1536 + col]; pp.w2 = cw[3072 + col]; pp.bs = cb[col]; pp.bias = bias1;
    long_conv<LOGL, 1, 1>(cx, yst, kf_ptr<LOGL>(p, 1, c, 0), kf_ptr<LOGL>(p, 1, c, 1), buf, pp);
  }
  __syncthreads();
#pragma unroll 2
  for (int i = 0; i < NQ; ++i) {
    const int t = 4 * (tid + 256 * i);
    float2 y[4];
    ld4(hy_zptr<LOGL>(cx.base, t), y);
    uint2 oa, ob;
    oa.x = pack2(y[0].x, y[1].x); oa.y = pack2(y[2].x, y[3].x);
    ob.x = pack2(y[0].y, y[1].y); ob.y = pack2(y[2].y, y[3].y);
    *(uint2*)(x2a + t) = oa;
    *(uint2*)(x2b + t) = ob;
  }
}

__device__ void attn_item(const Params& p, int item, char* smem) {
  const int tid = ltid(), lane = tid & 63, wave = tid >> 6, l15 = lane & 15, g = lane >> 4;
  int b, h, qb, LOG; size_t tok0, vtb;
  if (item < 4096) { qb = item & 63; h = (item >> 6) & 7; b = item >> 9; LOG = 13; tok0 = (size_t)b * 8192; vtb = ((size_t)((b * 8 + h) * 64)) << 13; }
  else { const int it = item - 4096; qb = it & 31; h = (it >> 5) & 7; b = it >> 8; LOG = 12; tok0 = TPR + (size_t)b * 4096;
         vtb = (size_t)TPR * 512 + (((size_t)((b * 8 + h) * 64)) << 12); }
  const int nkt = (1 << LOG) >> 6;
  const u16* Qn = (const u16*)(p.ws + OFF_Q);
  const u16* Qr = Qn + (size_t)NT * 512;
  const u16* knb = (const u16*)(p.ws + OFF_K) + tok0 * 512 + h * 64;
  const u16* krb = (const u16*)(p.ws + OFF_KR) + tok0 * 32;
  const u16* vbase = (const u16*)(p.ws + OFF_VT) + vtb;
  const size_t q0 = tok0 + (size_t)qb * 128 + wave * 32;
  bf16x8 qf[2][3];
#pragma unroll
  for (int qt = 0; qt < 2; ++qt)
#pragma unroll
    for (int ks = 0; ks < 3; ++ks) qf[qt][ks] = (ks < 2) ? *(const bf16x8*)(Qn + (q0 + qt * 16 + l15) * 512 + h * 64 + ks * 32 + g * 8)
                                                  : *(const bf16x8*)(Qr + (q0 + qt * 16 + l15) * 256 + h * 32 + g * 8);
#define KKEY(i) ((tid + 256 * (i)) / 12)
#define KCH(i) ((tid + 256 * (i)) % 12)
#define KSRC(kt_, i) ((KCH(i) < 8) ? (knb + (size_t)((kt_) * 64 + KKEY(i)) * 512 + KCH(i) * 8) : (krb + (size_t)((kt_) * 64 + KKEY(i)) * 32 + (KCH(i) - 8) * 8))
  const int vd0 = tid >> 3, vch = tid & 7;
  u32x4 rk0, rk1, rk2, rv0, rv1;
  rk0 = *(const u32x4*)KSRC(0, 0); rk1 = *(const u32x4*)KSRC(0, 1); rk2 = *(const u32x4*)KSRC(0, 2);
  rv0 = *(const u32x4*)(vbase + ((size_t)(vd0) << LOG) + vch * 8);
  rv1 = *(const u32x4*)(vbase + ((size_t)(vd0 + 32) << LOG) + vch * 8);
  *(u32x4*)(smem + KKEY(0) * 208 + KCH(0) * 16) = rk0;
  *(u32x4*)(smem + KKEY(1) * 208 + KCH(1) * 16) = rk1;
  *(u32x4*)(smem + KKEY(2) * 208 + KCH(2) * 16) = rk2;
  *(u32x4*)(smem + 13312 + (vd0) * 144 + vch * 16) = rv0;
  *(u32x4*)(smem + 13312 + (vd0 + 32) * 144 + vch * 16) = rv1;
  __syncthreads();
  f32x4 o[4][2];
#pragma unroll
  for (int dt = 0; dt < 4; ++dt) { o[dt][0] = f32x4{0.f, 0.f, 0.f, 0.f}; o[dt][1] = f32x4{0.f, 0.f, 0.f, 0.f}; }
  float mrun[2] = {-1e30f, -1e30f}, lrun[2] = {0.f, 0.f};
  for (int kt = 0; kt < nkt; ++kt) {
    const int ktn = (kt + 1 < nkt) ? (kt + 1) : kt;
    rk0 = gload128(KSRC(ktn, 0)); rk1 = gload128(KSRC(ktn, 1)); rk2 = gload128(KSRC(ktn, 2));
    rv0 = gload128(vbase + ((size_t)(vd0) << LOG) + ktn * 64 + vch * 8);
    rv1 = gload128(vbase + ((size_t)(vd0 + 32) << LOG) + ktn * 64 + vch * 8);
    __builtin_amdgcn_sched_barrier(0);
    const char* ks_ = smem + (kt & 1) * 22528;
    const char* vs_ = ks_ + 13312;
    f32x4 st[4][2];
#pragma unroll
    for (int kti = 0; kti < 4; ++kti) { st[kti][0] = f32x4{0.f, 0.f, 0.f, 0.f}; st[kti][1] = f32x4{0.f, 0.f, 0.f, 0.f}; }
    __builtin_amdgcn_s_setprio(1);
#pragma unroll
    for (int ks = 0; ks < 3; ++ks)
#pragma unroll
      for (int kti = 0; kti < 4; ++kti) {
        const bf16x8 kf = *(const bf16x8*)(ks_ + (kti * 16 + l15) * 208 + (ks * 4 + g) * 16);
        st[kti][0] = __builtin_amdgcn_mfma_f32_16x16x32_bf16(kf, qf[0][ks], st[kti][0], 0, 0, 0);
        st[kti][1] = __builtin_amdgcn_mfma_f32_16x16x32_bf16(kf, qf[1][ks], st[kti][1], 0, 0, 0);
      }
    __builtin_amdgcn_s_setprio(0);
    bf16x8 pfa[2], pfb[2];
#pragma unroll
    for (int qt = 0; qt < 2; ++qt) {
      float mx = st[0][qt][0];
#pragma unroll
      for (int kti = 0; kti < 4; ++kti)
#pragma unroll
        for (int j = 0; j < 4; ++j) mx = fmaxf(mx, st[kti][qt][j]);
      mx = fmaxf(mx, __shfl_xor(mx, 16));
      mx = fmaxf(mx, __shfl_xor(mx, 32));
      const float mnew = fmaxf(mrun[qt], mx);
      const float alpha = __builtin_amdgcn_exp2f(mrun[qt] - mnew);
      mrun[qt] = mnew;
      float ls = 0.f;
      u32x4 pw0, pw1;
#pragma unroll
      for (int kti = 0; kti < 4; ++kti) {
        const float p0 = __builtin_amdgcn_exp2f(st[kti][qt][0] - mnew), p1 = __builtin_amdgcn_exp2f(st[kti][qt][1] - mnew);
        const float p2 = __builtin_amdgcn_exp2f(st[kti][qt][2] - mnew), p3 = __builtin_amdgcn_exp2f(st[kti][qt][3] - mnew);
        ls += (p0 + p1) + (p2 + p3);
        const unsigned wa = pack2(p0, p1), wb = pack2(p2, p3);
        if (kti == 0) { pw0[0] = wa; pw0[1] = wb; } else if (kti == 1) { pw0[2] = wa; pw0[3] = wb; }
        else if (kti == 2) { pw1[0] = wa; pw1[1] = wb; } else { pw1[2] = wa; pw1[3] = wb; }
      }
      if (qt == 0) { pfa[0] = __builtin_bit_cast(bf16x8, pw0); pfa[1] = __builtin_bit_cast(bf16x8, pw1); }
      else { pfb[0] = __builtin_bit_cast(bf16x8, pw0); pfb[1] = __builtin_bit_cast(bf16x8, pw1); }
      lrun[qt] = lrun[qt] * alpha + ls;
#pragma unroll
      for (int dt = 0; dt < 4; ++dt) {
        o[dt][qt][0] *= alpha; o[dt][qt][1] *= alpha; o[dt][qt][2] *= alpha; o[dt][qt][3] *= alpha;
      }
    }
    __builtin_amdgcn_s_setprio(1);
#pragma unroll
    for (int kk = 0; kk < 2; ++kk)
#pragma unroll
      for (int dt = 0; dt < 4; ++dt) {
        const char* va = vs_ + (dt * 16 + l15) * 144 + (kk * 32 + g * 4) * 2;
        const s16x4 lo = *(const s16x4*)va;
        const s16x4 hi = *(const s16x4*)(va + 32);
        const bf16x8 vf = __builtin_shufflevector(lo, hi, 0, 1, 2, 3, 4, 5, 6, 7);
        o[dt][0] = __builtin_amdgcn_mfma_f32_16x16x32_bf16(vf, pfa[kk], o[dt][0], 0, 0, 0);
        o[dt][1] = __builtin_amdgcn_mfma_f32_16x16x32_bf16(vf, pfb[kk], o[dt][1], 0, 0, 0);
      }
    __builtin_amdgcn_s_setprio(0);
    __builtin_amdgcn_sched_barrier(0);
    vm_wait0();
    {
      char* dk = smem + ((kt + 1) & 1) * 22528;
      *(u32x4*)(dk + KKEY(0) * 208 + KCH(0) * 16) = rk0;
      *(u32x4*)(dk + KKEY(1) * 208 + KCH(1) * 16) = rk1;
      *(u32x4*)(dk + KKEY(2) * 208 + KCH(2) * 16) = rk2;
      *(u32x4*)(dk + 13312 + (vd0) * 144 + vch * 16) = rv0;
      *(u32x4*)(dk + 13312 + (vd0 + 32) * 144 + vch * 16) = rv1;
    }
    __syncthreads();
  }
  u16* MIX = (u16*)(p.ws + OFF_MIX);
#pragma unroll
  for (int qt = 0; qt < 2; ++qt) {
    float l = lrun[qt];
    l += __shfl_xor(l, 16); l += __shfl_xor(l, 32);
    const float inv = 1.f / l;
    const size_t row = q0 + qt * 16 + l15;
#pragma unroll
    for (int dt = 0; dt < 4; ++dt) {
      uint2 pk;
      pk.x = pack2(o[dt][qt][0] * inv, o[dt][qt][1] * inv);
      pk.y = pack2(o[dt][qt][2] * inv, o[dt][qt][3] * inv);
      *(uint2*)(MIX + row * 1024 + 512 + h * 64 + dt * 16 + g * 4) = pk;
    }
  }
}

__device__ void ropek_job(const Params& p, int job) {
  const int tid = ltid();
  const int row = job * 16 + (tid >> 4), j = tid & 15;
  const u16* Pq = (const u16*)(p.ws + OFF_PQ) + (size_t)row * 768 + 640;
  const float* rc = (const float*)(p.ws + OFF_SMALL + ROPEC_O);
  const float* rsn = (const float*)(p.ws + OFF_SMALL + ROPES_O);
  const int pos = seq_pos(row);
  const float c = rc[pos * 16 + j], s = rsn[pos * 16 + j];
  const float x1 = bf2f(Pq[j]), x2 = bf2f(Pq[16 + j]);
  const u16 o1 = f2bf(x1 * c - x2 * s), o2 = f2bf(x1 * s + x2 * c);
  u16* Kr = (u16*)(p.ws + OFF_KR) + (size_t)row * 32;
  Kr[j] = o1; Kr[16 + j] = o2;
}

__device__ void ztrans_item(const Params& p, int item, char* smem) {
  u16* sm = (u16*)smem;
  const int tid = ltid();
  const int tt = item >> 3, ct = item & 7;
  const int row0 = tt * 64, c0 = ct * 64;
  const u16* Ut = (const u16*)(p.ws + OFF_UT);
  {
    const int cc = tid >> 2, tq = (tid & 3) * 16;
    const u16* src = Ut + ut_index(row0 + tq, 512 + c0 + cc);
    const uint4 v0 = *(const uint4*)src, v1 = *(const uint4*)(src + 8);
    *(uint4*)(sm + cc * 72 + tq) = v0;
    *(uint4*)(sm + cc * 72 + tq + 8) = v1;
  }
  __syncthreads();
  {
    const int t = tid >> 2, cq = (tid & 3) * 16;
    unsigned w[8];
#pragma unroll
    for (int i = 0; i < 8; ++i) w[i] = (unsigned)sm[(cq + 2 * i) * 72 + t] | ((unsigned)sm[(cq + 2 * i + 1) * 72 + t] << 16);
    u16* dst = (u16*)(p.ws + OFF_MIX) + (size_t)(row0 + t) * 1024 + c0 + cq;
    *(uint4*)dst = make_uint4(w[0], w[1], w[2], w[3]);
    *(uint4*)(dst + 8) = make_uint4(w[4], w[5], w[6], w[7]);
  }
  __syncthreads();
}

__device__ void rs_rows(const Params& p, size_t part_off) {
  const float* part = (const float*)(p.ws + part_off);
  float* RS = (float*)(p.ws + OFF_SMALL + SS_O);
  for (int row = blockIdx.x * 256 + ltid(); row < NT; row += gridDim.x * 256) RS[row] = row_rs16(part, row);
}

template <int HW> __device__ __forceinline__ void pooldiff_body(const Params& p, int row, int ch) {
  const float* RS = (const float*)(p.ws + OFF_SMALL + SS_O);
  const u16* xb = (const u16*)(p.ws + OFF_XB);
  const int L = row < TPR ? 8192 : 4096;
  const int pos = seq_pos(row);
  float acc[8] = {0.f, 0.f, 0.f, 0.f, 0.f, 0.f, 0.f, 0.f};
  float self[8] = {0.f, 0.f, 0.f, 0.f, 0.f, 0.f, 0.f, 0.f};
#pragma unroll
  for (int d = -HW; d < HW; ++d) {
    const int q = pos + d;
    const bool ok = (q >= 0) && (q < L);
    const int r = ok ? (row + d) : row;
    const float rs = ok ? RS[r] : 0.f;
    const uint4 v = *(const uint4*)(xb + (size_t)r * 1024 + ch * 8);
    const unsigned w[4] = {v.x, v.y, v.z, v.w};
#pragma unroll
    for (int i = 0; i < 4; ++i) {
      const float f0 = __uint_as_float(w[i] << 16) * rs, f1 = __uint_as_float(w[i] & 0xffff0000u) * rs;
      acc[2 * i] += f0; acc[2 * i + 1] += f1;
      if (d == 0) { self[2 * i] = f0; self[2 * i + 1] = f1; }
    }
  }
  const int lo = max(pos - HW, 0), hi = min(pos + HW, L);
  const float invn = 1.f / (float)(hi - lo);
  uint4 o;
  o.x = pack2(acc[0] * invn - self[0], acc[1] * invn - self[1]);
  o.y = pack2(acc[2] * invn - self[2], acc[3] * invn - self[3]);
  o.z = pack2(acc[4] * invn - self[4], acc[5] * invn - self[5]);
  o.w = pack2(acc[6] * invn - self[6], acc[7] * invn - self[7]);
  *(uint4*)((u16*)(p.ws + OFF_D) + (size_t)row * 1024 + ch * 8) = o;
}
__device__ void pooldiff_job(const Params& p, int layer, int job) {
  (void)layer;
  const int tid = ltid();
  const int row = job * 2 + (tid >> 7), ch = tid & 127;
  const int gi = ch >> 5;
  if (gi == 0) pooldiff_body<1>(p, row, ch);
  else if (gi == 1) pooldiff_body<2>(p, row, ch);
  else if (gi == 2) pooldiff_body<4>(p, row, ch);
  else pooldiff_body<8>(p, row, ch);
}

__device__ void final_rows(const Params& p) {
  int G = gridDim.x; asm volatile("" : "+s"(G));
  const int bid = blockIdx.x, tid = ltid();
  const float* RSv = (const float*)(p.ws + OFF_SMALL + SS_O);
  const float4 gv = *(const float4*)(p.final_norm + tid * 4);
  for (int row = bid; row < NT; row += G) {
    const float rs = RSv[row];
    float4 v = *(float4*)(p.out + (size_t)row * 1024 + tid * 4);
    v.x *= rs * gv.x; v.y *= rs * gv.y; v.z *= rs * gv.z; v.w *= rs * gv.w;
    *(float4*)(p.out + (size_t)row * 1024 + tid * 4) = v;
  }
}

enum { K_PREP, K_E1A, K_E1, K_E2A, K_E2B, K_E2C, K_E2D, K_E3A, K_E3H13, K_E3H12, K_E3B, K_E4, K_RSA, K_M1, K_M2, K_RSB, K_O1, K_O2 , K_FINAL };
constexpr int NPHASE = 1 + 2 * (15 + 6) + 1;
__device__ __forceinline__ void phase_decode(int ph, int& kind, int& layer) {
  if (ph == 0) { kind = K_PREP; layer = 0; return; }
  if (ph == NPHASE - 1) { kind = K_FINAL; layer = 0; return; }
  int q = ph - 1;
  const int pair = q / 21; q -= pair * 21;
  if (q < 15) { layer = pair * 2; kind = K_E1A + q; }
  else { layer = pair * 2 + 1; q -= 15; kind = (q == 0) ? K_O1 : (q == 1) ? K_O2 : (q == 2) ? K_RSA : (q == 3) ? K_M1 : (q == 4) ? K_M2 : K_RSB; }
}

__device__ void run_phase(const Params& p, int ph, char* smem) {
  int kind, layer;
  phase_decode(ph, kind, layer);
  int G = gridDim.x; asm volatile("" : "+s"(G));
  const int bid = blockIdx.x;
  const int e = layer >> 1;
#ifdef ONLY_KIND
  if (kind != ONLY_KIND) return;
#endif
  switch (kind) {
    case K_PREP: phase_prep(p, smem); break;
    case K_E1A: for (int j = bid; j < 192; j += G) h2_job(p, e, j, smem); break;
    case K_E1: for (int j = bid; j < 11520; j += G) tile_win(p, e, j, smem); break;
    case K_E2A:
      for (int j = bid; j < 1024; j += G) filt_job<13>(p, e, j >> 9, j & 511, smem);
      for (int j = bid; j < 1024; j += G) filt_job<12>(p, e, j >> 9, j & 511, smem);
      break;
    case K_E2B: for (int j = bid; j < 3840; j += G) tile_uq(p, e, j, smem); break;
    case K_E2C: for (int j = bid; j < 5120; j += G) tile_ukv(p, e, j, smem); break;
    case K_E2D: for (int j = bid; j < 5120; j += G) ropek_job(p, j); break;
    case K_E3A:
      if (G == 512) {
        const int x = bid & 7, slot = bid >> 3;
        for (int r = 0; r < 8; ++r) attn_item(p, ((r * 8 + x) << 6) | slot, smem);
        for (int r = 0; r < 2; ++r) attn_item(p, 4096 + (((r * 16 + x * 2 + (slot >> 5)) << 5) | (slot & 31)), smem);
      } else {
        for (int j = bid; j < 5120; j += G) attn_item(p, j, smem);
      }
      break;
    case K_E3H13: for (int j = bid; j < 2048; j += G) hyena_job<13>(p, e, j >> 2, (j & 3) * 2, smem); break;
    case K_E3H12: for (int j = bid; j < 1024; j += G) hyena_job<12>(p, e, j >> 1, (j & 1) * 2, smem); break;
    case K_E3B: for (int j = bid; j < 10240; j += G) ztrans_item(p, j, smem); break;
    case K_E4: for (int j = bid; j < 5120; j += G) tile_wout(p, layer, j, smem); break;
    case K_M1: for (int j = bid; j < 640 * 32; j += G) tile_mlp1(p, layer, j, smem); break;
    case K_M2: for (int j = bid; j < 5120; j += G) tile_mlp2(p, layer, j, smem); break;
    case K_RSA: rs_rows(p, OFF_PARTA); break;
    case K_RSB: rs_rows(p, OFF_PARTB); break;
    case K_O1: for (int j = bid; j < NT / 2; j += G) pooldiff_job(p, layer, j); break;
    case K_O2: for (int j = bid; j < 5120; j += G) tile_pool(p, layer, j, smem); break;
    case K_FINAL: final_rows(p); break;
  }
}


#define XB_TMO      128
#define XB_XCNT(j)  (256  + 64 * (j))
#define XB_XSUB(j)  (1280 + 64 * (j))
#define XB_XGEN(j)  (2304 + 64 * (j))
#define XB_TOP      3328
#define XB_TOPGEN   3392
#define XCD_BAR_WORDS 3456
#define XB_SPIN_CAP (1u << 22)
#define XB_LAS __attribute__((address_space(3)))
__device__ __forceinline__ unsigned xb_ld(unsigned* q) { return __hip_atomic_load(q, __ATOMIC_RELAXED, __HIP_MEMORY_SCOPE_AGENT); }
__device__ __forceinline__ unsigned xb_add(unsigned* q, unsigned v) { return __hip_atomic_fetch_add(q, v, __ATOMIC_RELAXED, __HIP_MEMORY_SCOPE_AGENT); }
__device__ __forceinline__ unsigned xb_xcc_id() { return (unsigned)__builtin_amdgcn_s_getreg((3 << 11) | 20) & 0xFu; }
#define XB_SPIN(cond, bar) do { unsigned _sp = 0; while (cond) { __builtin_amdgcn_s_sleep(1); \
    if ((++_sp & 255u) == 0u) { if (xb_ld(&(bar)[XB_TMO])) break; if (_sp > XB_SPIN_CAP) { atomicAdd(&(bar)[XB_TMO], 1u); break; } } } } while (0)
struct XcdBarrier { unsigned* bar; unsigned x; volatile XB_LAS unsigned* st; };
__device__ __forceinline__ XcdBarrier xcd_barrier_post(unsigned* bar, volatile XB_LAS unsigned* st) {
  XcdBarrier b; b.bar = bar; b.x = xb_xcc_id(); b.st = st;
  if (threadIdx.x == 0) (void)xb_add(&bar[XB_XCNT(b.x)], 1u);
  return b;
}
__device__ __forceinline__ void xcd_barrier_complete(unsigned* bar, unsigned x, unsigned& nloc, unsigned& nx) {
  const unsigned G = gridDim.x * gridDim.y * gridDim.z;
  unsigned sum, cnt, mine, sp = 0u;
  for (;;) {
    sum = 0u; cnt = 0u; mine = 0u;
#pragma unroll
    for (unsigned j = 0; j < 16; ++j) { const unsigned c = xb_ld(&bar[XB_XCNT(j)]); sum += c; cnt += (c > 0u) ? 1u : 0u; mine = (j == x) ? c : mine; }
    if (sum == G) break;
    __builtin_amdgcn_s_sleep(1);
    if ((++sp & 255u) == 0u) { if (xb_ld(&bar[XB_TMO])) break; if (sp > XB_SPIN_CAP) { atomicAdd(&bar[XB_TMO], 1u); break; } }
  }
  nloc = mine > 0u ? mine : 1u; nx = cnt > 0u ? cnt : 1u;
}
__device__ __forceinline__ void xcd_barrier(const XcdBarrier& b) {
  asm volatile("s_waitcnt vmcnt(0)" ::: "memory");
  __syncthreads();
  if (threadIdx.x == 0) {
    unsigned* bar = b.bar;
    __builtin_amdgcn_s_waitcnt(0);
    unsigned nloc = b.st[0], nx = b.st[1];
    if (nloc == 0u) { xcd_barrier_complete(bar, b.x, nloc, nx); b.st[0] = nloc; b.st[1] = nx; }
    const unsigned old = xb_add(&bar[XB_XSUB(b.x)], 1u);
    const unsigned gen = old / nloc;
    if (old + 1u == (gen + 1u) * nloc) {
      __builtin_amdgcn_fence(__ATOMIC_RELEASE, "agent");
      asm volatile("s_waitcnt vmcnt(0)" ::: "memory");
      const unsigned og = xb_add(&bar[XB_TOP], 1u);
      const unsigned tg = og / nx;
      if (og + 1u == (tg + 1u) * nx) xb_add(&bar[XB_TOPGEN], 1u);
      else XB_SPIN(xb_ld(&bar[XB_TOPGEN]) == tg, bar);
      __builtin_amdgcn_fence(__ATOMIC_ACQUIRE, "agent");
      xb_add(&bar[XB_XGEN(b.x)], 1u);
      asm volatile("s_waitcnt vmcnt(0)" ::: "memory");
    } else {
      XB_SPIN(xb_ld(&bar[XB_XGEN(b.x)]) == gen, bar);
      __builtin_amdgcn_fence(__ATOMIC_ACQUIRE, "agent");
      asm volatile("s_waitcnt vmcnt(0)" ::: "memory");
    }
  }
  __syncthreads();
}

__global__ void __launch_bounds__(256, 2) mega(Params p, int ph_lo, int ph_hi, int coop) {
  __shared__ __attribute__((aligned(16))) char smem[SMEM_BYTES];
  __shared__ __attribute__((aligned(16))) unsigned xb_st[4];
  if (threadIdx.x < 4) xb_st[threadIdx.x] = 0u;
  __syncthreads();
  XcdBarrier xb = xcd_barrier_post((unsigned*)(p.ws + OFF_BAR), (volatile XB_LAS unsigned*)xb_st);
  for (int ph = ph_lo; ph < ph_hi; ++ph) {
    run_phase(p, ph, smem);
    if (coop && ph + 1 < ph_hi) {
      if (ph == ph_lo) cg::this_grid().sync();
      else xcd_barrier(xb);
    }
  }
}

extern "C" void kernel_launch(void* const* d_in, const int* in_sizes, int n_in, void* d_out, int out_size, void* d_ws,
                              size_t ws_size, hipStream_t stream) {
  (void)in_sizes; (void)n_in; (void)out_size;
  if (ws_size < WS_NEED) { fprintf(stderr, "workspace too small: %zu < %zu\n", ws_size, (size_t)WS_NEED); return; }
  Params p;
  memset(&p, 0, sizeof(p));
  const float** pp = (const float**)&p;
  for (int i = 0; i < 24; ++i) pp[i] = (const float*)d_in[i];
  p.out = (float*)d_out;
  p.ws = (char*)d_ws;
  u16* W = (u16*)((char*)d_ws + OFF_W);
  int nt = 0, tiles = 0;
  auto add = [&](const float* src, u16* dst, const float* gk, const float* gn, int K, int N, int Npad, int perm) {
    ConvTask& t = p.tasks[nt++];
    t.src = src; t.dst = dst; t.gk = gk; t.gn = gn; t.K = K; t.N = N; t.Npad = Npad; t.perm = perm; t.tile0 = tiles; t.pad = 0;
    tiles += (K / 64) * (Npad / 64);
  };
  for (int i = 0; i < 4; ++i) {
    add(p.mlp_w1 + (size_t)i * 1024 * 4096, W + WM1_O + (size_t)i * 4096 * 1024, p.mlp_norm + i * 1024, nullptr, 1024, 4096, 4096, 0);
    add(p.mlp_w2 + (size_t)i * 4096 * 1024, W + WM2_O + (size_t)i * 4096 * 1024, nullptr, nullptr, 4096, 1024, 1024, 0);
  }
  for (int e = 0; e < 2; ++e) {
    add(p.w_in + (size_t)e * 1024 * 2208, W + WIN_O + (size_t)e * 2304 * 1024, p.mix_norm + (2 * e) * 1024, nullptr, 1024, 2208, 2304, 0);
    add(p.w_uq + (size_t)e * 384 * 768, W + WUQ_O + (size_t)e * 768 * 384, p.q_norm + e * 384, nullptr, 384, 768, 768, 1);
    add(p.w_ukv + (size_t)e * 256 * 1024, W + WUKV_O + (size_t)e * 1024 * 256, p.kv_norm + e * 256, nullptr, 256, 1024, 1024, 0);
    add(p.w_out + (size_t)e * 1024 * 1024, W + WOUT_O + (size_t)e * 1024 * 1024, nullptr, nullptr, 1024, 1024, 1024, 0);
  }
  for (int o = 0; o < 2; ++o)
    for (int gi = 0; gi < 4; ++gi)
      add(p.pool_w + (size_t)(o * 4 + gi) * 65536, W + WPOOL_O + (size_t)(o * 4 + gi) * 65536,
          p.mix_norm + (2 * o + 1) * 1024 + gi * 256, p.pool_scale + o * 1024 + gi * 256, 256, 256, 256, 0);
  p.ntasks = nt; p.total_conv_tiles = tiles;

  static int grid_blocks = 0;
  if (!grid_blocks) {
    int dev = 0, cus = 0, per_cu = 0;
    hipGetDevice(&dev);
    hipDeviceGetAttribute(&cus, hipDeviceAttributeMultiprocessorCount, dev);
    hipOccupancyMaxActiveBlocksPerMultiprocessor(&per_cu, mega, 256, 0);
    if (per_cu < 1) per_cu = 1;
    grid_blocks = cus * per_cu;
    if (grid_blocks > MAX_GRID) grid_blocks = MAX_GRID;
  }
#if MULTI_LAUNCH
  for (int ph = 0; ph < NPHASE; ++ph) hipLaunchKernelGGL(mega, dim3(grid_blocks), dim3(256), 0, stream, p, ph, ph + 1, 0);
#else
  hipMemsetAsync((char*)d_ws + OFF_BAR, 0, XCD_BAR_WORDS * sizeof(unsigned), stream);
  int lo = 0, hi = NPHASE, coop = 1;
  void* args[] = {&p, &lo, &hi, &coop};
  hipError_t err = hipLaunchCooperativeKernel((void*)mega, dim3(grid_blocks), dim3(256), args, 0, stream);
  if (err != hipSuccess) fprintf(stderr, "cooperative launch failed: %s (grid %d)\n", hipGetErrorString(err), grid_blocks);
#endif
}
```

```cpp
#include <hip/hip_runtime.h>
#include <hip/hip_cooperative_groups.h>
#include <cstdio>
#include <cstring>
#include <cstdint>
namespace cg = cooperative_groups;

#ifndef MULTI_LAUNCH
#define MULTI_LAUNCH 0
#endif

typedef unsigned short u16;
typedef __attribute__((ext_vector_type(8))) short bf16x8;
typedef __attribute__((ext_vector_type(4))) short s16x4;
typedef __attribute__((ext_vector_type(4))) float f32x4;
typedef __attribute__((ext_vector_type(4))) unsigned u32x4;

constexpr int NT = 81920;
constexpr int TPR = 65536;
constexpr float EPS = 1e-6f;
constexpr size_t MiB = 1048576;

constexpr size_t OFF_W = 0;
constexpr size_t WIN_O = 0;
constexpr size_t WUQ_O = WIN_O + 2ull * 2304 * 1024;
constexpr size_t WUKV_O = WUQ_O + 2ull * 768 * 384;
constexpr size_t WOUT_O = WUKV_O + 2ull * 1024 * 256;
constexpr size_t WPOOL_O = WOUT_O + 2ull * 1024 * 1024;
constexpr size_t WM1_O = WPOOL_O + 8ull * 256 * 256;
constexpr size_t WM2_O = WM1_O + 4ull * 4096 * 1024;
constexpr size_t W_END = WM2_O + 4ull * 4096 * 1024;
static_assert(W_END * 2 <= 88 * MiB, "weights region");
constexpr size_t OFF_SMALL = 88 * MiB;
constexpr size_t SS_O = 0;
constexpr size_t SSQ_O = SS_O + 9ull * NT * 4;
constexpr size_t SSKV_O = SSQ_O + 2ull * NT * 4;
constexpr size_t ROPEC_O = SSKV_O + 2ull * NT * 4;
constexpr size_t ROPES_O = ROPEC_O + 8192ull * 16 * 4;
constexpr size_t H2_O = ROPES_O + 8192ull * 16 * 4;
constexpr size_t SMALL_END = H2_O + 12288ull * 64 * 4;
static_assert(SMALL_END <= 10 * MiB, "small region");
constexpr size_t OFF_XB = 98 * MiB;
constexpr size_t OFF_Q = 98 * MiB;
constexpr size_t OFF_K = 218 * MiB;
constexpr size_t OFF_KR = 298 * MiB;
constexpr size_t OFF_UT = 303 * MiB;
constexpr size_t OFF_D = 303 * MiB;
constexpr size_t OFF_VT = 543 * MiB;
constexpr size_t OFF_MIX = 623 * MiB;
constexpr size_t OFF_PQ = 623 * MiB;
constexpr size_t OFF_KF = 783 * MiB;
constexpr size_t OFF_YST = 975 * MiB;
constexpr size_t OFF_HID = 258 * MiB;
constexpr size_t OFF_PARTA = 1007 * MiB;
constexpr size_t OFF_PARTB = OFF_PARTA + (size_t)NT * 64;
constexpr size_t OFF_PQS = OFF_PARTB + (size_t)NT * 64;
constexpr size_t OFF_PKVS = OFF_PQS + (size_t)NT * 32;
constexpr size_t OFF_BAR = 1021 * MiB;
constexpr size_t WS_NEED = 1022 * MiB;
static_assert(OFF_PKVS + (size_t)NT * 16 <= WS_NEED, "ws");
constexpr int MAX_GRID = 512;

constexpr int SMEM_BYTES = 67584;
#define PADI(i) ((i) + ((i) >> 5))

struct ConvTask { const float* src; u16* dst; const float* gk; const float* gn; int K, N, Npad, perm, tile0, pad; };

struct Params {
  const float *x_prompt, *x_sample, *mix_norm, *w_in, *hy_conv_w, *hy_conv_b, *hf_w1, *hf_b1, *hf_freq, *hf_w2,
      *hf_b2, *hf_w3, *hy_bias, *q_norm, *w_uq, *kv_norm, *w_ukv, *w_out, *pool_w, *pool_scale, *mlp_norm, *mlp_w1,
      *mlp_w2, *final_norm;
  float* out;
  char* ws;
  ConvTask tasks[24];
  int ntasks, total_conv_tiles;
};

typedef __bf16 hwbf2 __attribute__((ext_vector_type(2)));
typedef float hwf2 __attribute__((ext_vector_type(2)));
__device__ __forceinline__ unsigned pack2(float a, float b) {
  const hwf2 v = {a, b};
  return __builtin_bit_cast(unsigned, __builtin_convertvector(v, hwbf2));
}
__device__ __forceinline__ u16 f2bf(float f) { return (u16)(pack2(f, 0.f) & 0xffffu); }
__device__ __forceinline__ float bf2f(u16 h) { return __uint_as_float(((unsigned)h) << 16); }
__device__ __forceinline__ float2 cmul(float2 a, float2 b) { return make_float2(a.x * b.x - a.y * b.y, a.x * b.y + a.y * b.x); }
__device__ __forceinline__ float2 cmulc(float2 a, float2 b) { return make_float2(a.x * b.x + a.y * b.y, a.y * b.x - a.x * b.y); }
__device__ __forceinline__ float2 twid(float rev) { return make_float2(__builtin_amdgcn_cosf(rev), -__builtin_amdgcn_sinf(rev)); }
__device__ __forceinline__ float sin_acc(float x) {
  double r = (double)x * 0.15915494309189533577;
  r -= floor(r);
  return __builtin_amdgcn_sinf((float)r);
}
__device__ __forceinline__ float cos_acc(float x) {
  double r = (double)x * 0.15915494309189533577;
  r -= floor(r);
  return __builtin_amdgcn_cosf((float)r);
}
__device__ __forceinline__ int ltid() { int t = threadIdx.x; asm volatile("" : "+v"(t)); return t; }
__device__ __forceinline__ char* lws(char* w) { asm volatile("" : "+s"(w)); return w; }
__device__ __forceinline__ float2 ld_l2(const float2* q) {
  const unsigned long long v = __hip_atomic_load((const unsigned long long*)q, __ATOMIC_RELAXED, __HIP_MEMORY_SCOPE_AGENT);
  return make_float2(__uint_as_float((unsigned)v), __uint_as_float((unsigned)(v >> 32)));
}
__device__ __forceinline__ u32x4 gload128(const void* q) {
  u32x4 v;
  asm volatile("global_load_dwordx4 %0, %1, off" : "=&v"(v) : "v"(q) : "memory");
  return v;
}
__device__ __forceinline__ void vm_wait0() { asm volatile("s_waitcnt vmcnt(0)" ::: "memory"); }
__device__ __forceinline__ int seq_pos(int row) { return row < TPR ? (row & 8191) : (row & 4095); }
__device__ __forceinline__ size_t ut_index(int row, int col) {
  if (row < TPR) { int b = row >> 13, t = row & 8191; return (((size_t)(b * 1536 + col)) << 13) + t; }
  int r = row - TPR; int b = r >> 12, t = r & 4095;
  return (size_t)TPR * 1536 + (((size_t)(b * 1536 + col)) << 12) + t;
}
__device__ __forceinline__ size_t vt_index(int row, int h, int d) {
  if (row < TPR) { int b = row >> 13, t = row & 8191; return (((size_t)((b * 8 + h) * 64 + d)) << 13) + t; }
  int r = row - TPR; int b = r >> 12, t = r & 4095;
  return (size_t)TPR * 512 + (((size_t)((b * 8 + h) * 64 + d)) << 12) + t;
}
__device__ __forceinline__ float row_rs16(const float* part, int row) {
  float s = 0.f;
#pragma unroll
  for (int i = 0; i < 8; ++i) s += part[(size_t)i * NT + row];
  return rsqrtf(s * (1.f / 1024.f) + EPS);
}
__device__ __forceinline__ float red16(float v) {
  v += __shfl_xor(v, 1); v += __shfl_xor(v, 2); v += __shfl_xor(v, 4); v += __shfl_xor(v, 8);
  return v;
}

#define G_LOAD(RA, RB, KT)                                                              \
  {                                                                                     \
    const int kc_ = ((KT) < nk) ? (KT) : (nk - 1);                                      \
    _Pragma("unroll") for (int i = 0; i < 4; ++i) {                                     \
      RA[i] = gload128(ap + (size_t)(32 * i) * lda + kc_ * 64);                         \
      RB[i] = gload128(bp + (size_t)(32 * i) * ldb + kc_ * 64);                         \
    }                                                                                   \
  }
#define G_STORE(RA, RB, BUF)                                                            \
  {                                                                                     \
    char* da_ = smem + (BUF) * 32768;                                                   \
    _Pragma("unroll") for (int i = 0; i < 4; ++i) {                                     \
      *(u32x4*)(da_ + soff + i * 4096) = RA[i];                                         \
      *(u32x4*)(da_ + 16384 + soff + i * 4096) = RB[i];                                 \
    }                                                                                   \
  }
#define G_COMPUTE(BUF)                                                                  \
  {                                                                                     \
    const char* sa = smem + (BUF) * 32768;                                              \
    const char* sb = sa + 16384;                                                        \
    _Pragma("unroll") for (int ks = 0; ks < 2; ++ks) {                                  \
      bf16x8 af[4], bfr[4];                                                             \
      const int coff = (((ks * 4 + g) ^ sw) << 4);                                      \
      _Pragma("unroll") for (int mi = 0; mi < 4; ++mi)                                  \
        af[mi] = *(const bf16x8*)(sa + (wr * 64 + mi * 16 + l15) * 128 + coff);         \
      _Pragma("unroll") for (int ni = 0; ni < 4; ++ni)                                  \
        bfr[ni] = *(const bf16x8*)(sb + (wc * 64 + ni * 16 + l15) * 128 + coff);        \
      __builtin_amdgcn_s_setprio(1);                                                    \
      _Pragma("unroll") for (int mi = 0; mi < 4; ++mi)                                  \
        _Pragma("unroll") for (int ni = 0; ni < 4; ++ni)                                \
          acc[mi][ni] = __builtin_amdgcn_mfma_f32_16x16x32_bf16(af[mi], bfr[ni], acc[mi][ni], 0, 0, 0); \
      __builtin_amdgcn_s_setprio(0);                                                    \
    }                                                                                   \
  }
__device__ __forceinline__ void vm_wait8() { asm volatile("s_waitcnt vmcnt(8)" ::: "memory"); }

__device__ __forceinline__ void gemm_core(const u16* __restrict__ A, int lda, const u16* __restrict__ B, int ldb, int K,
                                          char* smem, f32x4 (&acc)[4][4]) {
  const int tid = ltid(), lane = tid & 63, wave = tid >> 6, wr = wave >> 1, wc = wave & 1;
  const int lrow = tid >> 3, lch = tid & 7;
  const int l15 = lane & 15, g = lane >> 4;
  const u16* ap = A + (size_t)lrow * lda + lch * 8;
  const u16* bp = B + (size_t)lrow * ldb + lch * 8;
  const int soff = lrow * 128 + ((lch ^ ((lrow >> 1) & 7)) << 4);
  const int sw = (l15 >> 1) & 7;
  const int nk = K >> 6;
  u32x4 ra0[4], rb0[4], ra1[4], rb1[4];
  G_LOAD(ra0, rb0, 0);
  G_LOAD(ra1, rb1, 1);
#pragma unroll
  for (int mi = 0; mi < 4; ++mi)
#pragma unroll
    for (int ni = 0; ni < 4; ++ni) acc[mi][ni] = f32x4{0.f, 0.f, 0.f, 0.f};
  vm_wait8();
  G_STORE(ra0, rb0, 0);
  __syncthreads();
  for (int kt = 0; kt < nk; kt += 2) {
    G_LOAD(ra0, rb0, kt + 2);
    __builtin_amdgcn_sched_barrier(0);
    G_COMPUTE(0);
    __builtin_amdgcn_sched_barrier(0);
    vm_wait8();
    G_STORE(ra1, rb1, 1);
    __syncthreads();
    G_LOAD(ra1, rb1, kt + 3);
    __builtin_amdgcn_sched_barrier(0);
    G_COMPUTE(1);
    __builtin_amdgcn_sched_barrier(0);
    vm_wait8();
    G_STORE(ra0, rb0, 0);
    __syncthreads();
  }
  vm_wait0();
#pragma unroll
  for (int i = 0; i < 4; ++i) asm volatile("" :: "v"(ra1[i]), "v"(rb1[i]));
}

#define EPI_COORDS                                                                     \
  const int tid_e = ltid(); const int lane = tid_e & 63, wave = tid_e >> 6, wr = wave >> 1, wc = wave & 1; \
  const int l15 = lane & 15, g = lane >> 4;                                             \
  (void)wr; (void)wc; (void)l15; (void)g;

__device__ __forceinline__ void store_rows_bf16(const u16* st, int ldst, u16* dst, size_t ldd, int tid) {
#pragma unroll
  for (int i = 0; i < 8; ++i) {
    const int c = tid + 256 * i, rl = c >> 4, cc = c & 15;
    *(uint4*)(dst + (size_t)rl * ldd + cc * 8) = *(const uint4*)(st + rl * ldst + cc * 8);
  }
}

__device__ void tile_win(const Params& p, int e, int tile, char* smem) {
  const int mt = tile / 18, nt = tile % 18;
  const int m0 = mt * 128, n0 = nt * 128;
  const u16* A = (const u16*)(p.ws + OFF_XB) + (size_t)m0 * 1024;
  const u16* B = (const u16*)(p.ws + OFF_W) + WIN_O + (size_t)e * 2304 * 1024 + (size_t)n0 * 1024;
  f32x4 acc[4][4];
  gemm_core(A, 1024, B, 1024, 1024, smem, acc);
  EPI_COORDS
  const float* RSv = (const float*)(p.ws + OFF_SMALL + SS_O);
  float* pqs = (float*)(p.ws + OFF_PQS);
  float* pkvs = (float*)(p.ws + OFF_PKVS);
  u16* st = (u16*)smem;
  const int colbase = n0 + wc * 64;
#pragma unroll
  for (int mi = 0; mi < 4; ++mi) {
    const int rl0 = wr * 64 + mi * 16 + g * 4;
    const int r0 = m0 + rl0;
    float rs[4];
#pragma unroll
    for (int j = 0; j < 4; ++j) rs[j] = RSv[r0 + j];
    if (nt < 12) {
#pragma unroll
      for (int ni = 0; ni < 4; ++ni) {
        uint2 pk;
        pk.x = pack2(acc[mi][ni][0] * rs[0], acc[mi][ni][1] * rs[1]);
        pk.y = pack2(acc[mi][ni][2] * rs[2], acc[mi][ni][3] * rs[3]);
        *(uint2*)(st + (wc * 64 + ni * 16 + l15) * 136 + rl0) = pk;
      }
    } else {
      float sq[4] = {0.f, 0.f, 0.f, 0.f};
#pragma unroll
      for (int ni = 0; ni < 4; ++ni)
#pragma unroll
        for (int j = 0; j < 4; ++j) {
          const float v = acc[mi][ni][j] * rs[j];
          sq[j] += v * v;
          st[(rl0 + j) * 136 + wc * 64 + ni * 16 + l15] = f2bf(v);
        }
      if (colbase < 2176) {
#pragma unroll
        for (int j = 0; j < 4; ++j) {
          float sm_ = red16(sq[j]);
          if (l15 == 0) {
            if (colbase < 1920) pqs[((size_t)(nt - 12) * NT + (r0 + j)) * 2 + wc] = sm_;
            else pkvs[((size_t)(nt - 15) * NT + (r0 + j)) * 2 + wc] = sm_;
          }
        }
      }
    }
  }
  __syncthreads();
  if (nt < 12) {
    u16* Ut = (u16*)(p.ws + OFF_UT);
#pragma unroll
    for (int i = 0; i < 8; ++i) {
      const int c = tid_e + 256 * i, cl = c >> 4, rc = c & 15;
      *(uint4*)(Ut + ut_index(m0 + rc * 8, n0 + cl)) = *(const uint4*)(st + cl * 136 + rc * 8);
    }
  } else {
    store_rows_bf16(st, 136, (u16*)(p.ws + OFF_PQ) + (size_t)m0 * 768 + (n0 - 1536), 768, tid_e);
  }
  __syncthreads();
}

__device__ void tile_uq(const Params& p, int e, int tile, char* smem) {
  const int mt = tile / 6, nt = tile % 6;
  const int m0 = mt * 128, n0 = nt * 128;
  const u16* A = (const u16*)(p.ws + OFF_PQ) + (size_t)m0 * 768;
  const u16* B = (const u16*)(p.ws + OFF_W) + WUQ_O + (size_t)e * 768 * 384 + (size_t)n0 * 384;
  f32x4 acc[4][4];
  gemm_core(A, 768, B, 384, 384, smem, acc);
  EPI_COORDS
  const float* pqs = (const float*)(p.ws + OFF_PQS);
  const float* rc = (const float*)(p.ws + OFF_SMALL + ROPEC_O);
  const float* rsn = (const float*)(p.ws + OFF_SMALL + ROPES_O);
  u16* st = (u16*)smem;
  const float qscale = 0.10206207261596577f * 1.4426950408889634f;
#pragma unroll
  for (int mi = 0; mi < 4; ++mi) {
    const int rl0 = wr * 64 + mi * 16 + g * 4;
#pragma unroll
    for (int j = 0; j < 4; ++j) {
      const int rl = rl0 + j, row = m0 + rl;
      const float2 qa = *(const float2*)(pqs + (size_t)row * 2), qb2 = *(const float2*)(pqs + ((size_t)NT + row) * 2), qc = *(const float2*)(pqs + ((size_t)2 * NT + row) * 2);
      const float rs = rsqrtf((((qa.x + qa.y) + (qb2.x + qb2.y)) + (qc.x + qc.y)) * (1.f / 384.f) + EPS) * qscale;
      if (nt < 4) {
#pragma unroll
        for (int ni = 0; ni < 4; ++ni) st[rl * 136 + wc * 64 + ni * 16 + l15] = f2bf(acc[mi][ni][j] * rs);
      } else {
        const int pos = seq_pos(row);
        const float c = rc[pos * 16 + l15], sn = rsn[pos * 16 + l15];
#pragma unroll
        for (int pp = 0; pp < 2; ++pp) {
          const float x1 = acc[mi][2 * pp][j] * rs, x2 = acc[mi][2 * pp + 1][j] * rs;
          st[rl * 136 + (wc * 2 + pp) * 32 + l15] = f2bf(x1 * c - x2 * sn);
          st[rl * 136 + (wc * 2 + pp) * 32 + 16 + l15] = f2bf(x1 * sn + x2 * c);
        }
      }
    }
  }
  __syncthreads();
  u16* Qn = (u16*)(p.ws + OFF_Q);
  u16* Qr = Qn + (size_t)NT * 512;
  if (nt < 4) store_rows_bf16(st, 136, Qn + (size_t)m0 * 512 + n0, 512, tid_e);
  else store_rows_bf16(st, 136, Qr + (size_t)m0 * 256 + (nt - 4) * 128, 256, tid_e);
  __syncthreads();
}

__device__ void tile_ukv(const Params& p, int e, int tile, char* smem) {
  const int mt = tile >> 3, h = tile & 7;
  const int m0 = mt * 128, n0 = h * 128;
  const u16* A = (const u16*)(p.ws + OFF_PQ) + (size_t)m0 * 768 + 384;
  const u16* B = (const u16*)(p.ws + OFF_W) + WUKV_O + (size_t)e * 1024 * 256 + (size_t)n0 * 256;
  f32x4 acc[4][4];
  gemm_core(A, 768, B, 256, 256, smem, acc);
  EPI_COORDS
  const float* pkvs = (const float*)(p.ws + OFF_PKVS);
  u16* stK = (u16*)smem;
  u16* stV = (u16*)(smem + 18432);
#pragma unroll
  for (int mi = 0; mi < 4; ++mi) {
    const int rl0 = wr * 64 + mi * 16 + g * 4;
    const int r0 = m0 + rl0;
    float rs[4];
#pragma unroll
    for (int j = 0; j < 4; ++j) { const float2 ka = *(const float2*)(pkvs + (size_t)(r0 + j) * 2), kb2 = *(const float2*)(pkvs + ((size_t)NT + r0 + j) * 2); rs[j] = rsqrtf(((ka.x + ka.y) + (kb2.x + kb2.y)) * (1.f / 256.f) + EPS); }
    if (wc == 0) {
#pragma unroll
      for (int ni = 0; ni < 4; ++ni)
#pragma unroll
        for (int j = 0; j < 4; ++j) stK[(rl0 + j) * 72 + ni * 16 + l15] = f2bf(acc[mi][ni][j] * rs[j]);
    } else {
#pragma unroll
      for (int ni = 0; ni < 4; ++ni) {
        uint2 pk;
        pk.x = pack2(acc[mi][ni][0] * rs[0], acc[mi][ni][1] * rs[1]);
        pk.y = pack2(acc[mi][ni][2] * rs[2], acc[mi][ni][3] * rs[3]);
        *(uint2*)(stV + (ni * 16 + l15) * 136 + rl0) = pk;
      }
    }
  }
  __syncthreads();
  u16* Kb = (u16*)(p.ws + OFF_K);
  u16* Vt = (u16*)(p.ws + OFF_VT);
#pragma unroll
  for (int i = 0; i < 4; ++i) {
    const int c = tid_e + 256 * i;
    { const int rl = c >> 3, cc = c & 7;
      *(uint4*)(Kb + (size_t)(m0 + rl) * 512 + h * 64 + cc * 8) = *(const uint4*)(stK + rl * 72 + cc * 8); }
    { const int d = c >> 4, rcx = c & 15;
      *(uint4*)(Vt + vt_index(m0 + rcx * 8, h, d)) = *(const uint4*)(stV + d * 136 + rcx * 8); }
  }
  __syncthreads();
}

__device__ __forceinline__ void epi_res(const Params& p, f32x4 (&acc)[4][4], int m0, int n0, const float* srcp,
                                        const float* srcs, float* ssn, char* smem) {
  EPI_COORDS
  float* st = (float*)smem;
#pragma unroll
  for (int mi = 0; mi < 4; ++mi)
#pragma unroll
    for (int ni = 0; ni < 4; ++ni)
#pragma unroll
      for (int j = 0; j < 4; ++j) st[(wr * 64 + mi * 16 + g * 4 + j) * 132 + wc * 64 + ni * 16 + l15] = acc[mi][ni][j];
  __syncthreads();
  u16* xb = (u16*)(p.ws + OFF_XB);
  const int cc = tid_e & 31, r8 = tid_e >> 5;
#pragma unroll 4
  for (int i = 0; i < 16; ++i) {
    const int rl = i * 8 + r8;
    const int row = m0 + rl;
    const float4 d = *(const float4*)(st + rl * 132 + cc * 4);
    const float* xin = (row < TPR) ? (srcp + (size_t)row * 1024) : (srcs + (size_t)(row - TPR) * 1024);
    const float4 x = *(const float4*)(xin + n0 + cc * 4);
    float4 xn; xn.x = x.x + d.x; xn.y = x.y + d.y; xn.z = x.z + d.z; xn.w = x.w + d.w;
    *(float4*)(p.out + (size_t)row * 1024 + n0 + cc * 4) = xn;
    uint2 pk; pk.x = pack2(xn.x, xn.y); pk.y = pack2(xn.z, xn.w);
    *(uint2*)(xb + (size_t)row * 1024 + n0 + cc * 4) = pk;
    float sq = xn.x * xn.x + xn.y * xn.y + xn.z * xn.z + xn.w * xn.w;
    sq += __shfl_xor(sq, 1); sq += __shfl_xor(sq, 2); sq += __shfl_xor(sq, 4); sq += __shfl_xor(sq, 8); sq += __shfl_xor(sq, 16);
    if (cc == 0) ssn[(size_t)(n0 >> 7) * NT + row] = sq;
  }
  __syncthreads();
}

__device__ void tile_wout(const Params& p, int layer, int tile, char* smem) {
  const int e = layer >> 1;
  const int mt = tile >> 3, nt = tile & 7;
  const int m0 = mt * 128, n0 = nt * 128;
  const u16* A = (const u16*)(p.ws + OFF_MIX) + (size_t)m0 * 1024;
  const u16* B = (const u16*)(p.ws + OFF_W) + WOUT_O + (size_t)e * 1024 * 1024 + (size_t)n0 * 1024;
  f32x4 acc[4][4];
  gemm_core(A, 1024, B, 1024, 1024, smem, acc);
  const float* sp = (layer == 0) ? p.x_prompt : p.out;
  const float* ssrc = (layer == 0) ? p.x_sample : (p.out + (size_t)TPR * 1024);
  epi_res(p, acc, m0, n0, sp, ssrc, (float*)(p.ws + OFF_PARTA), smem);
}

__device__ void tile_pool(const Params& p, int layer, int tile, char* smem) {
  const int o = layer >> 1;
  const int mt = tile >> 3, nt = tile & 7, gi = nt >> 1;
  const int m0 = mt * 128, n0 = nt * 128;
  const u16* A = (const u16*)(p.ws + OFF_D) + (size_t)m0 * 1024 + gi * 256;
  const u16* B = (const u16*)(p.ws + OFF_W) + WPOOL_O + (size_t)(o * 4 + gi) * 65536 + (size_t)(nt & 1) * 128 * 256;
  f32x4 acc[4][4];
  gemm_core(A, 1024, B, 256, 256, smem, acc);
  epi_res(p, acc, m0, n0, p.out, p.out + (size_t)TPR * 1024, (float*)(p.ws + OFF_PARTA), smem);
}

__device__ void tile_mlp1(const Params& p, int layer, int tile, char* smem) {
  (void)layer;
  const int mt = tile >> 5, nt = tile & 31;
  const int m0 = mt * 128, n0 = nt * 128;
  const u16* A = (const u16*)(p.ws + OFF_XB) + (size_t)m0 * 1024;
  const u16* B = (const u16*)(p.ws + OFF_W) + WM1_O + (size_t)layer * 4096 * 1024 + (size_t)n0 * 1024;
  f32x4 acc[4][4];
  gemm_core(A, 1024, B, 1024, 1024, smem, acc);
  EPI_COORDS
  const float* RSv = (const float*)(p.ws + OFF_SMALL + SS_O);
  u16* st = (u16*)smem;
#pragma unroll
  for (int mi = 0; mi < 4; ++mi) {
    const int rl0 = wr * 64 + mi * 16 + g * 4;
#pragma unroll
    for (int j = 0; j < 4; ++j) {
      const float rs = RSv[m0 + rl0 + j];
#pragma unroll
      for (int ni = 0; ni < 4; ++ni) {
        const float v = fmaxf(acc[mi][ni][j] * rs, 0.f);
        st[(rl0 + j) * 136 + wc * 64 + ni * 16 + l15] = f2bf(v * v);
      }
    }
  }
  __syncthreads();
  u16* Hd = (u16*)(p.ws + OFF_HID);
#pragma unroll
  for (int i = 0; i < 8; ++i) {
    const int c = tid_e + 256 * i, rl = c >> 4, cc = c & 15;
    const uint4 v = *(const uint4*)(st + rl * 136 + cc * 8);
    *(uint4*)(Hd + (size_t)(m0 + rl) * 4096 + n0 + cc * 8) = v;
  }
  __syncthreads();
}

__device__ void tile_mlp2(const Params& p, int layer, int tile, char* smem) {
  const int mt = tile >> 3, nt = tile & 7;
  const int m0 = mt * 128, n0 = nt * 128;
  const u16* A = (const u16*)(p.ws + OFF_HID) + (size_t)m0 * 4096;
  const u16* B = (const u16*)(p.ws + OFF_W) + WM2_O + (size_t)layer * 4096 * 1024 + (size_t)n0 * 4096;
  f32x4 acc[4][4];
  gemm_core(A, 4096, B, 4096, 4096, smem, acc);
  epi_res(p, acc, m0, n0, p.out, p.out + (size_t)TPR * 1024, (float*)(p.ws + OFF_PARTB), smem);
}

__device__ void conv_tile(const ConvTask& t, int tile, char* smem) {
  float* sm = (float*)smem;
  const int nkt = t.K >> 6;
  const int kt = tile % nkt, nt = tile / nkt;
  const int tid = ltid();
  {
    const int nn = tid & 63, k4 = tid >> 6;
    const int np = nt * 64 + nn;
    int ns = np;
    if (t.perm) ns = (np < 512) ? ((np >> 6) * 96 + (np & 63)) : (((np - 512) >> 5) * 96 + 64 + ((np - 512) & 31));
    const float gn = (t.gn && np < t.N) ? t.gn[ns] : 1.f;
#pragma unroll
    for (int r = 0; r < 16; ++r) {
      const int kk = k4 + 4 * r;
      const int k = kt * 64 + kk;
      float v = 0.f;
      if (np < t.N) {
        v = t.src[(size_t)k * t.N + ns] * gn;
        if (t.gk) v *= t.gk[k];
      }
      sm[kk * 65 + nn] = v;
    }
  }
  __syncthreads();
  {
    const int kk = tid & 63, n4 = tid >> 6;
#pragma unroll
    for (int r = 0; r < 16; ++r) {
      const int nn = n4 + 4 * r;
      t.dst[(size_t)(nt * 64 + nn) * t.K + kt * 64 + kk] = f2bf(sm[kk * 65 + nn]);
    }
  }
  __syncthreads();
}

__device__ void phase_prep(const Params& p, char* smem) {
  int G = gridDim.x; asm volatile("" : "+s"(G));
  const int bid = blockIdx.x, tid = ltid();
  for (int tile = bid; tile < p.total_conv_tiles; tile += G) {
    int ti = 0;
    for (int i = 1; i < p.ntasks; ++i)
      if (tile >= p.tasks[i].tile0) ti = i;
    conv_tile(p.tasks[ti], tile - p.tasks[ti].tile0, smem);
  }
#ifdef ZERO_WS
  {
    uint4* z = (uint4*)(p.ws + 258 * MiB);
    const size_t n = (size_t)(1007 - 258) * MiB / 16;
    for (size_t i = (size_t)bid * 256 + tid; i < n; i += (size_t)G * 256) z[i] = make_uint4(0u, 0u, 0u, 0u);
  }
#endif
  {
    float* rc = (float*)(p.ws + OFF_SMALL + ROPEC_O);
    float* rsn = (float*)(p.ws + OFF_SMALL + ROPES_O);
    for (int i = bid * 256 + tid; i < 8192 * 16; i += G * 256) {
      const int pos = i >> 4, j = i & 15;
      const float inv_freq = 1.0f / powf(10000.f, (float)(2 * j) / 32.f);
      const float ang = (float)pos * inv_freq;
      rc[i] = cos_acc(ang);
      rsn[i] = sin_acc(ang);
    }
  }
  {
    u16* xb = (u16*)(p.ws + OFF_XB);
    float* RSw = (float*)(p.ws + OFF_SMALL + SS_O);
    const int lane = tid & 63, wave = tid >> 6;
    for (int rr = bid * 16 + wave * 4; rr < NT; rr += G * 16)
    for (int row = rr; row < rr + 4; ++row) {
      const float* xr = (row < TPR) ? (p.x_prompt + (size_t)row * 1024) : (p.x_sample + (size_t)(row - TPR) * 1024);
      float sq = 0.f;
#pragma unroll
      for (int i = 0; i < 4; ++i) {
        const float4 v = *(const float4*)(xr + i * 256 + lane * 4);
        sq += v.x * v.x + v.y * v.y + v.z * v.z + v.w * v.w;
        uint2 pk; pk.x = pack2(v.x, v.y); pk.y = pack2(v.z, v.w);
        *(uint2*)(xb + (size_t)row * 1024 + i * 256 + lane * 4) = pk;
      }
      sq += __shfl_xor(sq, 1); sq += __shfl_xor(sq, 2); sq += __shfl_xor(sq, 4);
      sq += __shfl_xor(sq, 8); sq += __shfl_xor(sq, 16); sq += __shfl_xor(sq, 32);
      if (lane == 0) RSw[row] = rsqrtf(sq * (1.f / 1024.f) + EPS);
    }
  }
}

__device__ void h2_job(const Params& p, int e, int job, char* smem) {
  float* zs = (float*)smem;
  float* h1s = zs + 4 * 36;
  const int tid = ltid(), u = tid & 63, tq = tid >> 6;
  int L, tbase; float* H2;
  if (job < 128) { L = 8192; tbase = job * 64; H2 = (float*)(p.ws + OFF_SMALL + H2_O); }
  else { L = 4096; tbase = (job - 128) * 64; H2 = (float*)(p.ws + OFF_SMALL + H2_O) + 8192 * 64; }
  const float* w1 = p.hf_w1 + (size_t)e * 33 * 64;
  const float* w2 = p.hf_w2 + (size_t)e * 64 * 64;
  const float b1 = p.hf_b1[e * 64 + u], b2 = p.hf_b2[e * 64 + u], fr = p.hf_freq[e * 64 + u];
  for (int it = 0; it < 16; ++it) {
    const int t = tbase + it * 4 + tq;
    if (u < 33) {
      float z;
      if (u == 0) z = (float)t / (float)(L - 1);
      else {
        const int j = (u - 1) & 15;
        const float band = 1e-4f + (float)j * ((15.f - 1e-4f) / 15.f);
        const float wpos = (6.283185307179586f / (float)L) * (float)t;
        const float ang = band * wpos;
        z = (u <= 16) ? cos_acc(ang) : -sin_acc(ang);
      }
      zs[tq * 36 + u] = z;
    }
    __syncthreads();
    float a = b1;
#pragma unroll
    for (int i = 0; i < 33; ++i) a += zs[tq * 36 + i] * w1[i * 64 + u];
    h1s[tq * 64 + u] = sin_acc(fr * a);
    __syncthreads();
    float a2 = b2;
#pragma unroll 8
    for (int i = 0; i < 64; ++i) a2 += h1s[tq * 64 + i] * w2[i * 64 + u];
    H2[(size_t)t * 64 + u] = sin_acc(fr * a2);
    __syncthreads();
  }
}

__device__ __forceinline__ float2 w16c(int k) {
  switch (k) {
    case 0: return make_float2(1.f, 0.f);
    case 1: return make_float2(0.9238795325112867f, -0.3826834323650898f);
    case 2: return make_float2(0.7071067811865476f, -0.7071067811865476f);
    case 3: return make_float2(0.3826834323650898f, -0.9238795325112867f);
    case 4: return make_float2(0.f, -1.f);
    case 5: return make_float2(-0.3826834323650898f, -0.9238795325112867f);
    case 6: return make_float2(-0.7071067811865476f, -0.7071067811865476f);
    default: return make_float2(-0.9238795325112867f, -0.3826834323650898f);
  }
}

template <int R, int HALF, bool INV, bool HASW>
__device__ __forceinline__ void fft_stage(float2 (&x)[R], const float2 wk) {
#pragma unroll
  for (int bs = 0; bs < R; bs += 2 * HALF) {
#pragma unroll
    for (int jj = 0; jj < HALF; ++jj) {
      const float2 c = w16c(jj * 8 / HALF);
      float2 t;
      if (HASW) t = (jj == 0) ? wk : cmul(wk, c); else t = c;
      const float2 a = x[bs + jj];
      if (!INV) {
        const float2 b = x[bs + jj + HALF];
        const float2 d = make_float2(a.x - b.x, a.y - b.y);
        x[bs + jj] = make_float2(a.x + b.x, a.y + b.y);
        x[bs + jj + HALF] = (!HASW && jj == 0) ? d : cmul(d, t);
      } else {
        const float2 b = (!HASW && jj == 0) ? x[bs + jj + HALF] : cmulc(x[bs + jj + HALF], t);
        x[bs + jj] = make_float2(a.x + b.x, a.y + b.y);
        x[bs + jj + HALF] = make_float2(a.x - b.x, a.y - b.y);
      }
    }
  }
}

template <int LOGR, int SLOG, bool INV, int LOGL>
__device__ __forceinline__ void fft_pass(float2* buf) {
  constexpr int R = 1 << LOGR, S = 1 << SLOG, L = 1 << LOGL, NB = L / R;
  constexpr bool HASW = (SLOG > 0);
  const int tid_f = ltid();
#pragma unroll 1
  for (int q = tid_f; q < NB; q += 256) {
    const int lo = q & (S - 1), hi = q >> SLOG;
    const int base = (hi << (SLOG + LOGR)) + lo;
    float2 x[R];
#pragma unroll
    for (int j = 0; j < R; ++j) x[j] = buf[PADI(base + j * S)];
    float2 w1 = make_float2(1.f, 0.f);
    if (HASW) w1 = twid((float)lo * (1.f / (float)(R * S)));
    const float2 w2 = cmul(w1, w1), w4 = cmul(w2, w2), w8 = cmul(w4, w4);
    if (R == 16) {
      if (!INV) { fft_stage<R, R / 2, INV, HASW>(x, w1); fft_stage<R, R / 4, INV, HASW>(x, w2); fft_stage<R, R / 8, INV, HASW>(x, w4); fft_stage<R, (R >= 16 ? R / 16 : 1), INV, HASW>(x, w8); }
      else { fft_stage<R, (R >= 16 ? R / 16 : 1), INV, HASW>(x, w8); fft_stage<R, R / 8, INV, HASW>(x, w4); fft_stage<R, R / 4, INV, HASW>(x, w2); fft_stage<R, R / 2, INV, HASW>(x, w1); }
    } else {
      if (!INV) { fft_stage<R, R / 2, INV, HASW>(x, w1); fft_stage<R, R / 4, INV, HASW>(x, w2); fft_stage<R, R / 8, INV, HASW>(x, w4); }
      else { fft_stage<R, R / 8, INV, HASW>(x, w4); fft_stage<R, R / 4, INV, HASW>(x, w2); fft_stage<R, R / 2, INV, HASW>(x, w1); }
    }
#pragma unroll
    for (int j = 0; j < R; ++j) buf[PADI(base + j * S)] = x[j];
  }
  __syncthreads();
}

template <int LOGL> __device__ __forceinline__ void fft_fwd(float2* buf) {
  if (LOGL == 13) {
    fft_pass<4, 9, false, LOGL>(buf); fft_pass<3, 6, false, LOGL>(buf); fft_pass<3, 3, false, LOGL>(buf); fft_pass<3, 0, false, LOGL>(buf);
  } else {
    fft_pass<3, 9, false, LOGL>(buf); fft_pass<3, 6, false, LOGL>(buf); fft_pass<3, 3, false, LOGL>(buf); fft_pass<3, 0, false, LOGL>(buf);
  }
}
template <int LOGL> __device__ __forceinline__ void fft_inv(float2* buf) {
  if (LOGL == 13) {
    fft_pass<3, 0, true, LOGL>(buf); fft_pass<3, 3, true, LOGL>(buf); fft_pass<3, 6, true, LOGL>(buf); fft_pass<4, 9, true, LOGL>(buf);
  } else {
    fft_pass<3, 0, true, LOGL>(buf); fft_pass<3, 3, true, LOGL>(buf); fft_pass<3, 6, true, LOGL>(buf); fft_pass<3, 9, true, LOGL>(buf);
  }
}

template <int LOGL> __device__ __forceinline__ void fft_fwd_head(float2* buf) {
  if (LOGL == 13) { fft_pass<4, 9, false, LOGL>(buf); fft_pass<3, 6, false, LOGL>(buf); fft_pass<3, 3, false, LOGL>(buf); }
  else { fft_pass<3, 9, false, LOGL>(buf); fft_pass<3, 6, false, LOGL>(buf); fft_pass<3, 3, false, LOGL>(buf); }
}
template <int LOGL> __device__ __forceinline__ void fft_inv_tail(float2* buf) {
  if (LOGL == 13) { fft_pass<3, 3, true, LOGL>(buf); fft_pass<3, 6, true, LOGL>(buf); fft_pass<4, 9, true, LOGL>(buf); }
  else { fft_pass<3, 3, true, LOGL>(buf); fft_pass<3, 6, true, LOGL>(buf); fft_pass<3, 9, true, LOGL>(buf); }
}
template <int LOGL> __device__ __forceinline__ void fft_mid(float2* buf, const float2* __restrict__ Kf) {
  constexpr int L = 1 << LOGL, NB = L / 8;
  const int tid_f = ltid();
#pragma unroll 1
  for (int q = tid_f; q < NB; q += 256) {
    const int base = q << 3;
    float2 x[8], k[8];
#pragma unroll
    for (int j = 0; j < 8; ++j) x[j] = buf[PADI(base) + j];
    {
      const float4 k0 = *(const float4*)(Kf + base), k1 = *(const float4*)(Kf + base + 2);
      const float4 k2 = *(const float4*)(Kf + base + 4), k3 = *(const float4*)(Kf + base + 6);
      k[0] = make_float2(k0.x, k0.y); k[1] = make_float2(k0.z, k0.w); k[2] = make_float2(k1.x, k1.y); k[3] = make_float2(k1.z, k1.w);
      k[4] = make_float2(k2.x, k2.y); k[5] = make_float2(k2.z, k2.w); k[6] = make_float2(k3.x, k3.y); k[7] = make_float2(k3.z, k3.w);
    }
    const float2 one = make_float2(1.f, 0.f);
    fft_stage<8, 4, false, false>(x, one); fft_stage<8, 2, false, false>(x, one); fft_stage<8, 1, false, false>(x, one);
#pragma unroll
    for (int j = 0; j < 8; ++j) x[j] = cmul(x[j], k[j]);
    fft_stage<8, 1, true, false>(x, one); fft_stage<8, 2, true, false>(x, one); fft_stage<8, 4, true, false>(x, one);
#pragma unroll
    for (int j = 0; j < 8; ++j) buf[PADI(base) + j] = x[j];
  }
  __syncthreads();
}

template <int LOGL> __device__ __forceinline__ float2* kf_ptr(const Params& p, int filt, int c, int half) {
  float2* base = (float2*)(p.ws + OFF_KF);
  if (LOGL == 12) base += (size_t)2 * 512 * 2 * 8192;
  return base + ((size_t)((filt * 512 + c) * 2 + half) << LOGL);
}

template <int LOGL> __device__ void filt_job(const Params& p, int e, int filt, int c, char* smem) {
  constexpr int L = 1 << LOGL, NE = L / 256;
  float2* buf = (float2*)smem;
  float* w3s = (float*)(smem + SMEM_BYTES - 512);
  const int tid = ltid();
  const float* H2 = (const float*)(p.ws + OFF_SMALL + H2_O) + (LOGL == 12 ? 8192 * 64 : 0);
  const float* w3 = p.hf_w3 + (size_t)e * 64 * 2048;
  if (tid < 128) {
    const int dir = tid >> 6, u = tid & 63;
    w3s[tid] = w3[(size_t)u * 2048 + dir * 1024 + filt * 512 + c];
  }
  __syncthreads();
  const float min_decay = -3.0701134573253945f, max_decay = -15.350567286626972f;
  const float delta = fabsf(min_decay + (max_decay - min_decay) * ((float)c / 511.f));
  {
    const int lane = tid & 63, wave = tid >> 6, rl = lane >> 2, q4 = lane & 3;
    constexpr int NIT = L / 64;
#pragma unroll 2
    for (int it = 0; it < NIT; ++it) {
      const int t = it * 64 + wave * 16 + rl;
      const float4* hr = (const float4*)(H2 + (size_t)t * 64 + q4 * 16);
      float af = 0.f, ab = 0.f;
#pragma unroll
      for (int q = 0; q < 4; ++q) {
        const float4 h = hr[q];
        const float* wf = w3s + q4 * 16 + q * 4;
        af += h.x * wf[0] + h.y * wf[1] + h.z * wf[2] + h.w * wf[3];
        ab += h.x * wf[64] + h.y * wf[65] + h.z * wf[66] + h.w * wf[67];
      }
      af += __shfl_xor(af, 1); ab += __shfl_xor(ab, 1);
      af += __shfl_xor(af, 2); ab += __shfl_xor(ab, 2);
      const float tl = (float)t / (float)(L - 1);
      const float dec = __expf(-tl * delta);
      if (it == NIT - 1) __syncthreads();
      if (q4 == 0) buf[PADI(t)] = make_float2(af * dec, ab * dec);
    }
  }
  __syncthreads();
  float2* dstE = kf_ptr<LOGL>(p, filt, c, 0);
  float2* dstO = kf_ptr<LOGL>(p, filt, c, 1);
#pragma unroll 2
  for (int i = 0; i < NE / 2; ++i) {
    const int u = tid + 256 * i;
    const int t0 = u, t1 = (u == 0) ? (L / 2) : (L - u);
    const float2 e0 = buf[PADI(t0)], e1 = buf[PADI(t1)];
    const float a0 = e0.x, b0 = (u == 0) ? 0.f : e1.y;
    const float a1 = e1.x, b1f = (u == 0) ? e1.y : e0.y;
    const float2 w0 = twid((float)t0 * (1.f / (float)(2 * L))), w1 = twid((float)t1 * (1.f / (float)(2 * L)));
    const float d0 = a0 - b0, d1 = a1 - b1f;
    dstO[t0] = make_float2(d0 * w0.x, d0 * w0.y);
    dstO[t1] = make_float2(d1 * w1.x, d1 * w1.y);
    buf[PADI(t0)] = make_float2(a0 + b0, 0.f);
    buf[PADI(t1)] = make_float2(a1 + b1f, 0.f);
  }
  __syncthreads();
  fft_fwd<LOGL>(buf);
  const float nrm = 1.f / (float)(2 * L);
#pragma unroll 4
  for (int i = 0; i < NE; ++i) { const float2 v = buf[PADI(tid + 256 * i)]; dstE[tid + 256 * i] = make_float2(v.x * nrm, v.y * nrm); }
  __syncthreads();
#pragma unroll 2
  for (int i = 0; i < NE / 2; ++i) {
    const int u = tid + 256 * i;
    const int t0 = u, t1 = (u == 0) ? (L / 2) : (L - u);
    buf[PADI(t0)] = dstO[t0];
    buf[PADI(t1)] = dstO[t1];
  }
  __syncthreads();
  fft_fwd<LOGL>(buf);
#pragma unroll 4
  for (int i = 0; i < NE; ++i) { const float2 v = buf[PADI(tid + 256 * i)]; dstO[tid + 256 * i] = make_float2(v.x * nrm, v.y * nrm); }
  __syncthreads();
}

__device__ __forceinline__ void short_conv4(const u16* u, int t, int L, float w0, float w1, float w2, float bias, float (&o)[4]) {
  const uint2 mid = *(const uint2*)(u + t);
  const int tm = (t > 0) ? t - 1 : 0, tp = (t + 4 < L) ? t + 4 : L - 1;
  const float vm = bf2f(u[tm]), vp = bf2f(u[tp]);
  const float um = (t > 0) ? vm : 0.f, up = (t + 4 < L) ? vp : 0.f;
  const float u0 = __uint_as_float(mid.x << 16), u1 = __uint_as_float(mid.x & 0xffff0000u);
  const float u2 = __uint_as_float(mid.y << 16), u3 = __uint_as_float(mid.y & 0xffff0000u);
  o[0] = w0 * um + w1 * u0 + w2 * u1 + bias;
  o[1] = w0 * u0 + w1 * u1 + w2 * u2 + bias;
  o[2] = w0 * u1 + w1 * u2 + w2 * u3 + bias;
  o[3] = w0 * u2 + w1 * u3 + w2 * up + bias;
}

struct HyCtx { u16* base; float w0, w1, w2, bs; };
template <int LOGL> __device__ __forceinline__ float2* hy_zptr(u16* base, int t) {
  constexpr int L = 1 << LOGL;
  const int ch = t >> (LOGL - 2);
  u16* b = base + (((size_t)((ch & 1) * 1536 + (ch >> 1) * 1024)) << LOGL);
  return (float2*)b + (t & (L / 4 - 1));
}
__device__ __forceinline__ void ld4(const float2* q, float2 (&e)[4]) {
  const float4 a = *(const float4*)q, b = *(const float4*)(q + 2);
  e[0] = make_float2(a.x, a.y); e[1] = make_float2(a.z, a.w); e[2] = make_float2(b.x, b.y); e[3] = make_float2(b.z, b.w);
}
__device__ __forceinline__ void st4(float2* q, const float2 (&e)[4]) {
  *(float4*)q = make_float4(e[0].x, e[0].y, e[1].x, e[1].y);
  *(float4*)(q + 2) = make_float4(e[2].x, e[2].y, e[3].x, e[3].y);
}
template <int LOGL, int SRC> __device__ __forceinline__ void hy_a4(const HyCtx c, int t, float2 (&e)[4]) {
  constexpr int L = 1 << LOGL;
  if (SRC == 0) {
    const u16* va = c.base + ((size_t)1024 << LOGL);
    const u16* vb = c.base + ((size_t)(1536 + 1024) << LOGL);
    float sa[4], sb[4];
    short_conv4(va, t, L, c.w0, c.w1, c.w2, c.bs, sa);
    short_conv4(vb, t, L, c.w0, c.w1, c.w2, c.bs, sb);
#pragma unroll
    for (int k = 0; k < 4; ++k) e[k] = make_float2(sa[k], sb[k]);
  } else {
    ld4(hy_zptr<LOGL>(c.base, t), e);
  }
}

struct HyPost { const u16 *xa, *xb; float w0, w1, w2, bs, bias; };
template <int LOGL, int SRC>
__device__ __forceinline__ void long_conv(const HyCtx c, float2* yst, const float2* KE, const float2* KO, float2* buf, const HyPost pp) {
  constexpr int L = 1 << LOGL, NQ = L / 1024;
  const int tid = ltid();
#pragma unroll 4
  for (int i = 0; i < NQ; ++i) {
    const int t = 4 * (tid + 256 * i);
    float2 a[4];
    hy_a4<LOGL, SRC>(c, t, a);
#pragma unroll
    for (int k = 0; k < 4; ++k) buf[PADI(t) + k] = a[k];
  }
  __syncthreads();
  fft_fwd_head<LOGL>(buf);
  fft_mid<LOGL>(buf, KE);
  fft_inv_tail<LOGL>(buf);
#pragma unroll 4
  for (int i = 0; i < NQ; ++i) {
    const int t = 4 * (tid + 256 * i);
    float2 v[4];
#pragma unroll
    for (int k = 0; k < 4; ++k) v[k] = buf[PADI(t) + k];
    st4(yst + t, v);
  }
  __syncthreads();
#pragma unroll 4
  for (int i = 0; i < NQ; ++i) {
    const int t = 4 * (tid + 256 * i);
    float2 a[4];
    hy_a4<LOGL, SRC>(c, t, a);
#pragma unroll
    for (int k = 0; k < 4; ++k) buf[PADI(t) + k] = cmul(a[k], twid((float)(t + k) * (1.f / (float)(2 * L))));
  }
  __syncthreads();
  fft_fwd_head<LOGL>(buf);
  fft_mid<LOGL>(buf, KO);
  fft_inv_tail<LOGL>(buf);
#pragma unroll 4
  for (int i = 0; i < NQ; ++i) {
    const int t = 4 * (tid + 256 * i);
    float2 y[4], a[4];
    float xa[4], xb_[4];
    ld4(yst + t, y);
    hy_a4<LOGL, SRC>(c, t, a);
    short_conv4(pp.xa, t, L, pp.w0, pp.w1, pp.w2, pp.bs, xa);
    short_conv4(pp.xb, t, L, pp.w0, pp.w1, pp.w2, pp.bs, xb_);
#pragma unroll
    for (int k = 0; k < 4; ++k) {
      const float2 v = cmulc(buf[PADI(t) + k], twid((float)(t + k) * (1.f / (float)(2 * L))));
      y[k] = make_float2((y[k].x + v.x + pp.bias * a[k].x) * xa[k], (y[k].y + v.y + pp.bias * a[k].y) * xb_[k]);
    }
    st4(yst + t, y);
  }
  __syncthreads();
}

template <int LOGL> __device__ void hyena_job(const Params& p, int e, int c, int b0, char* smem) {
  constexpr int L = 1 << LOGL, NQ = L / 1024;
  float2* buf = (float2*)smem;
  const int tid = ltid();
  float2* yst = (float2*)(p.ws + OFF_YST) + (size_t)blockIdx.x * 8192;
  u16* Ut = (u16*)(p.ws + OFF_UT) + (LOGL == 12 ? (size_t)TPR * 1536 : 0);
  u16* x1a = Ut + (((size_t)(b0 * 1536 + c)) << LOGL);
  u16* x1b = Ut + (((size_t)((b0 + 1) * 1536 + c)) << LOGL);
  u16* x2a = x1a + ((size_t)512 << LOGL); u16* x2b = x1b + ((size_t)512 << LOGL);
  const float* cw = p.hy_conv_w + (size_t)e * 3 * 1536;
  const float* cb = p.hy_conv_b + (size_t)e * 1536;
  const float bias0 = p.hy_bias[(size_t)e * 1024 + c], bias1 = p.hy_bias[(size_t)e * 1024 + 512 + c];
  HyCtx cx;
  cx.base = x1a;
  cx.w0 = cw[1024 + c]; cx.w1 = cw[1536 + 1024 + c]; cx.w2 = cw[3072 + 1024 + c]; cx.bs = cb[1024 + c];
  {
    HyPost pp; pp.xa = x1a; pp.xb = x1b; pp.w0 = cw[c]; pp.w1 = cw[1536 + c]; pp.w2 = cw[3072 + c]; pp.bs = cb[c]; pp.bias = bias0;
    long_conv<LOGL, 0>(cx, yst, kf_ptr<LOGL>(p, 0, c, 0), kf_ptr<LOGL>(p, 0, c, 1), buf, pp);
  }
  __syncthreads();
#pragma unroll 4
  for (int i = 0; i < NQ; ++i) {
    const int t = 4 * (tid + 256 * i);
    float2 y[4];
    ld4(yst + t, y);
    st4(hy_zptr<LOGL>(cx.base, t), y);
  }
  {
    const int col = 512 + c;
    HyPost pp; pp.xa = x2a; pp.xb = x2b; pp.w0 = cw[col]; pp.w1 = cw[1536 + col]; pp.w2 = cw[3072 + col]; pp.bs = cb[col]; pp.bias = bias1;
    long_conv<LOGL, 1>(cx, yst, kf_ptr<LOGL>(p, 1, c, 0), kf_ptr<LOGL>(p, 1, c, 1), buf, pp);
  }
  __syncthreads();
#pragma unroll 4
  for (int i = 0; i < NQ; ++i) {
    const int t = 4 * (tid + 256 * i);
    float2 y[4];
    ld4(yst + t, y);
    uint2 oa, ob;
    oa.x = pack2(y[0].x, y[1].x); oa.y = pack2(y[2].x, y[3].x);
    ob.x = pack2(y[0].y, y[1].y); ob.y = pack2(y[2].y, y[3].y);
    *(uint2*)(x2a + t) = oa;
    *(uint2*)(x2b + t) = ob;
  }
}

__device__ void attn_item(const Params& p, int item, char* smem) {
  const int tid = ltid(), lane = tid & 63, wave = tid >> 6, l15 = lane & 15, g = lane >> 4;
  int b, h, qb, LOG; size_t tok0, vtb;
  if (item < 4096) { qb = item & 63; h = (item >> 6) & 7; b = item >> 9; LOG = 13; tok0 = (size_t)b * 8192; vtb = ((size_t)((b * 8 + h) * 64)) << 13; }
  else { const int it = item - 4096; qb = it & 31; h = (it >> 5) & 7; b = it >> 8; LOG = 12; tok0 = TPR + (size_t)b * 4096;
         vtb = (size_t)TPR * 512 + (((size_t)((b * 8 + h) * 64)) << 12); }
  const int nkt = (1 << LOG) >> 6;
  const u16* Qn = (const u16*)(p.ws + OFF_Q);
  const u16* Qr = Qn + (size_t)NT * 512;
  const u16* knb = (const u16*)(p.ws + OFF_K) + tok0 * 512 + h * 64;
  const u16* krb = (const u16*)(p.ws + OFF_KR) + tok0 * 32;
  const u16* vbase = (const u16*)(p.ws + OFF_VT) + vtb;
  const size_t q0 = tok0 + (size_t)qb * 128 + wave * 32;
  bf16x8 qf[2][3];
#pragma unroll
  for (int qt = 0; qt < 2; ++qt)
#pragma unroll
    for (int ks = 0; ks < 3; ++ks) qf[qt][ks] = (ks < 2) ? *(const bf16x8*)(Qn + (q0 + qt * 16 + l15) * 512 + h * 64 + ks * 32 + g * 8)
                                                  : *(const bf16x8*)(Qr + (q0 + qt * 16 + l15) * 256 + h * 32 + g * 8);
#define KKEY(i) ((tid + 256 * (i)) / 12)
#define KCH(i) ((tid + 256 * (i)) % 12)
#define KSRC(kt_, i) ((KCH(i) < 8) ? (knb + (size_t)((kt_) * 64 + KKEY(i)) * 512 + KCH(i) * 8) : (krb + (size_t)((kt_) * 64 + KKEY(i)) * 32 + (KCH(i) - 8) * 8))
  const int vd0 = tid >> 3, vch = tid & 7;
  u32x4 rk0, rk1, rk2, rv0, rv1;
  rk0 = *(const u32x4*)KSRC(0, 0); rk1 = *(const u32x4*)KSRC(0, 1); rk2 = *(const u32x4*)KSRC(0, 2);
  rv0 = *(const u32x4*)(vbase + ((size_t)(vd0) << LOG) + vch * 8);
  rv1 = *(const u32x4*)(vbase + ((size_t)(vd0 + 32) << LOG) + vch * 8);
  *(u32x4*)(smem + KKEY(0) * 208 + KCH(0) * 16) = rk0;
  *(u32x4*)(smem + KKEY(1) * 208 + KCH(1) * 16) = rk1;
  *(u32x4*)(smem + KKEY(2) * 208 + KCH(2) * 16) = rk2;
  *(u32x4*)(smem + 13312 + (vd0) * 144 + vch * 16) = rv0;
  *(u32x4*)(smem + 13312 + (vd0 + 32) * 144 + vch * 16) = rv1;
  __syncthreads();
  f32x4 o[4][2];
#pragma unroll
  for (int dt = 0; dt < 4; ++dt) { o[dt][0] = f32x4{0.f, 0.f, 0.f, 0.f}; o[dt][1] = f32x4{0.f, 0.f, 0.f, 0.f}; }
  float mrun[2] = {-1e30f, -1e30f}, lrun[2] = {0.f, 0.f};
  for (int kt = 0; kt < nkt; ++kt) {
    const int ktn = (kt + 1 < nkt) ? (kt + 1) : kt;
    rk0 = gload128(KSRC(ktn, 0)); rk1 = gload128(KSRC(ktn, 1)); rk2 = gload128(KSRC(ktn, 2));
    rv0 = gload128(vbase + ((size_t)(vd0) << LOG) + ktn * 64 + vch * 8);
    rv1 = gload128(vbase + ((size_t)(vd0 + 32) << LOG) + ktn * 64 + vch * 8);
    __builtin_amdgcn_sched_barrier(0);
    const char* ks_ = smem + (kt & 1) * 22528;
    const char* vs_ = ks_ + 13312;
    f32x4 st[4][2];
#pragma unroll
    for (int kti = 0; kti < 4; ++kti) { st[kti][0] = f32x4{0.f, 0.f, 0.f, 0.f}; st[kti][1] = f32x4{0.f, 0.f, 0.f, 0.f}; }
    __builtin_amdgcn_s_setprio(1);
#pragma unroll
    for (int ks = 0; ks < 3; ++ks)
#pragma unroll
      for (int kti = 0; kti < 4; ++kti) {
        const bf16x8 kf = *(const bf16x8*)(ks_ + (kti * 16 + l15) * 208 + (ks * 4 + g) * 16);
        st[kti][0] = __builtin_amdgcn_mfma_f32_16x16x32_bf16(kf, qf[0][ks], st[kti][0], 0, 0, 0);
        st[kti][1] = __builtin_amdgcn_mfma_f32_16x16x32_bf16(kf, qf[1][ks], st[kti][1], 0, 0, 0);
      }
    __builtin_amdgcn_s_setprio(0);
    bf16x8 pfa[2], pfb[2];
#pragma unroll
    for (int qt = 0; qt < 2; ++qt) {
      float mx = st[0][qt][0];
#pragma unroll
      for (int kti = 0; kti < 4; ++kti)
#pragma unroll
        for (int j = 0; j < 4; ++j) mx = fmaxf(mx, st[kti][qt][j]);
      mx = fmaxf(mx, __shfl_xor(mx, 16));
      mx = fmaxf(mx, __shfl_xor(mx, 32));
      const float mnew = fmaxf(mrun[qt], mx);
      const float alpha = __builtin_amdgcn_exp2f(mrun[qt] - mnew);
      mrun[qt] = mnew;
      float ls = 0.f;
      u32x4 pw0, pw1;
#pragma unroll
      for (int kti = 0; kti < 4; ++kti) {
        const float p0 = __builtin_amdgcn_exp2f(st[kti][qt][0] - mnew), p1 = __builtin_amdgcn_exp2f(st[kti][qt][1] - mnew);
        const float p2 = __builtin_amdgcn_exp2f(st[kti][qt][2] - mnew), p3 = __builtin_amdgcn_exp2f(st[kti][qt][3] - mnew);
        ls += (p0 + p1) + (p2 + p3);
        const unsigned wa = pack2(p0, p1), wb = pack2(p2, p3);
        if (kti == 0) { pw0[0] = wa; pw0[1] = wb; } else if (kti == 1) { pw0[2] = wa; pw0[3] = wb; }
        else if (kti == 2) { pw1[0] = wa; pw1[1] = wb; } else { pw1[2] = wa; pw1[3] = wb; }
      }
      if (qt == 0) { pfa[0] = __builtin_bit_cast(bf16x8, pw0); pfa[1] = __builtin_bit_cast(bf16x8, pw1); }
      else { pfb[0] = __builtin_bit_cast(bf16x8, pw0); pfb[1] = __builtin_bit_cast(bf16x8, pw1); }
      lrun[qt] = lrun[qt] * alpha + ls;
#pragma unroll
      for (int dt = 0; dt < 4; ++dt) {
        o[dt][qt][0] *= alpha; o[dt][qt][1] *= alpha; o[dt][qt][2] *= alpha; o[dt][qt][3] *= alpha;
      }
    }
    __builtin_amdgcn_s_setprio(1);
#pragma unroll
    for (int kk = 0; kk < 2; ++kk)
#pragma unroll
      for (int dt = 0; dt < 4; ++dt) {
        const char* va = vs_ + (dt * 16 + l15) * 144 + (kk * 32 + g * 4) * 2;
        const s16x4 lo = *(const s16x4*)va;
        const s16x4 hi = *(const s16x4*)(va + 32);
        const bf16x8 vf = __builtin_shufflevector(lo, hi, 0, 1, 2, 3, 4, 5, 6, 7);
        o[dt][0] = __builtin_amdgcn_mfma_f32_16x16x32_bf16(vf, pfa[kk], o[dt][0], 0, 0, 0);
        o[dt][1] = __builtin_amdgcn_mfma_f32_16x16x32_bf16(vf, pfb[kk], o[dt][1], 0, 0, 0);
      }
    __builtin_amdgcn_s_setprio(0);
    __builtin_amdgcn_sched_barrier(0);
    vm_wait0();
    {
      char* dk = smem + ((kt + 1) & 1) * 22528;
      *(u32x4*)(dk + KKEY(0) * 208 + KCH(0) * 16) = rk0;
      *(u32x4*)(dk + KKEY(1) * 208 + KCH(1) * 16) = rk1;
      *(u32x4*)(dk + KKEY(2) * 208 + KCH(2) * 16) = rk2;
      *(u32x4*)(dk + 13312 + (vd0) * 144 + vch * 16) = rv0;
      *(u32x4*)(dk + 13312 + (vd0 + 32) * 144 + vch * 16) = rv1;
    }
    __syncthreads();
  }
  u16* MIX = (u16*)(p.ws + OFF_MIX);
#pragma unroll
  for (int qt = 0; qt < 2; ++qt) {
    float l = lrun[qt];
    l += __shfl_xor(l, 16); l += __shfl_xor(l, 32);
    const float inv = 1.f / l;
    const size_t row = q0 + qt * 16 + l15;
#pragma unroll
    for (int dt = 0; dt < 4; ++dt) {
      uint2 pk;
      pk.x = pack2(o[dt][qt][0] * inv, o[dt][qt][1] * inv);
      pk.y = pack2(o[dt][qt][2] * inv, o[dt][qt][3] * inv);
      *(uint2*)(MIX + row * 1024 + 512 + h * 64 + dt * 16 + g * 4) = pk;
    }
  }
}

__device__ void ropek_job(const Params& p, int job) {
  const int tid = ltid();
  const int row = job * 16 + (tid >> 4), j = tid & 15;
  const u16* Pq = (const u16*)(p.ws + OFF_PQ) + (size_t)row * 768 + 640;
  const float* rc = (const float*)(p.ws + OFF_SMALL + ROPEC_O);
  const float* rsn = (const float*)(p.ws + OFF_SMALL + ROPES_O);
  const int pos = seq_pos(row);
  const float c = rc[pos * 16 + j], s = rsn[pos * 16 + j];
  const float x1 = bf2f(Pq[j]), x2 = bf2f(Pq[16 + j]);
  const u16 o1 = f2bf(x1 * c - x2 * s), o2 = f2bf(x1 * s + x2 * c);
  u16* Kr = (u16*)(p.ws + OFF_KR) + (size_t)row * 32;
  Kr[j] = o1; Kr[16 + j] = o2;
}

__device__ void ztrans_item(const Params& p, int item, char* smem) {
  u16* sm = (u16*)smem;
  const int tid = ltid();
  const int tt = item >> 3, ct = item & 7;
  const int row0 = tt * 64, c0 = ct * 64;
  const u16* Ut = (const u16*)(p.ws + OFF_UT);
  {
    const int cc = tid >> 2, tq = (tid & 3) * 16;
    const u16* src = Ut + ut_index(row0 + tq, 512 + c0 + cc);
    const uint4 v0 = *(const uint4*)src, v1 = *(const uint4*)(src + 8);
    *(uint4*)(sm + cc * 72 + tq) = v0;
    *(uint4*)(sm + cc * 72 + tq + 8) = v1;
  }
  __syncthreads();
  {
    const int t = tid >> 2, cq = (tid & 3) * 16;
    unsigned w[8];
#pragma unroll
    for (int i = 0; i < 8; ++i) w[i] = (unsigned)sm[(cq + 2 * i) * 72 + t] | ((unsigned)sm[(cq + 2 * i + 1) * 72 + t] << 16);
    u16* dst = (u16*)(p.ws + OFF_MIX) + (size_t)(row0 + t) * 1024 + c0 + cq;
    *(uint4*)dst = make_uint4(w[0], w[1], w[2], w[3]);
    *(uint4*)(dst + 8) = make_uint4(w[4], w[5], w[6], w[7]);
  }
  __syncthreads();
}

__device__ void rs_rows(const Params& p, size_t part_off) {
  const float* part = (const float*)(p.ws + part_off);
  float* RS = (float*)(p.ws + OFF_SMALL + SS_O);
  for (int row = blockIdx.x * 256 + ltid(); row < NT; row += gridDim.x * 256) RS[row] = row_rs16(part, row);
}

template <int HW> __device__ __forceinline__ void pooldiff_body(const Params& p, int row, int ch) {
  const float* RS = (const float*)(p.ws + OFF_SMALL + SS_O);
  const u16* xb = (const u16*)(p.ws + OFF_XB);
  const int L = row < TPR ? 8192 : 4096;
  const int pos = seq_pos(row);
  float acc[8] = {0.f, 0.f, 0.f, 0.f, 0.f, 0.f, 0.f, 0.f};
  float self[8] = {0.f, 0.f, 0.f, 0.f, 0.f, 0.f, 0.f, 0.f};
#pragma unroll
  for (int d = -HW; d < HW; ++d) {
    const int q = pos + d;
    const bool ok = (q >= 0) && (q < L);
    const int r = ok ? (row + d) : row;
    const float rs = ok ? RS[r] : 0.f;
    const uint4 v = *(const uint4*)(xb + (size_t)r * 1024 + ch * 8);
    const unsigned w[4] = {v.x, v.y, v.z, v.w};
#pragma unroll
    for (int i = 0; i < 4; ++i) {
      const float f0 = __uint_as_float(w[i] << 16) * rs, f1 = __uint_as_float(w[i] & 0xffff0000u) * rs;
      acc[2 * i] += f0; acc[2 * i + 1] += f1;
      if (d == 0) { self[2 * i] = f0; self[2 * i + 1] = f1; }
    }
  }
  const int lo = max(pos - HW, 0), hi = min(pos + HW, L);
  const float invn = 1.f / (float)(hi - lo);
  uint4 o;
  o.x = pack2(acc[0] * invn - self[0], acc[1] * invn - self[1]);
  o.y = pack2(acc[2] * invn - self[2], acc[3] * invn - self[3]);
  o.z = pack2(acc[4] * invn - self[4], acc[5] * invn - self[5]);
  o.w = pack2(acc[6] * invn - self[6], acc[7] * invn - self[7]);
  *(uint4*)((u16*)(p.ws + OFF_D) + (size_t)row * 1024 + ch * 8) = o;
}
__device__ void pooldiff_job(const Params& p, int layer, int job) {
  (void)layer;
  const int tid = ltid();
  const int row = job * 2 + (tid >> 7), ch = tid & 127;
  const int gi = ch >> 5;
  if (gi == 0) pooldiff_body<1>(p, row, ch);
  else if (gi == 1) pooldiff_body<2>(p, row, ch);
  else if (gi == 2) pooldiff_body<4>(p, row, ch);
  else pooldiff_body<8>(p, row, ch);
}

__device__ void final_rows(const Params& p) {
  int G = gridDim.x; asm volatile("" : "+s"(G));
  const int bid = blockIdx.x, tid = ltid();
  const float* RSv = (const float*)(p.ws + OFF_SMALL + SS_O);
  const float4 gv = *(const float4*)(p.final_norm + tid * 4);
  for (int row = bid; row < NT; row += G) {
    const float rs = RSv[row];
    float4 v = *(float4*)(p.out + (size_t)row * 1024 + tid * 4);
    v.x *= rs * gv.x; v.y *= rs * gv.y; v.z *= rs * gv.z; v.w *= rs * gv.w;
    *(float4*)(p.out + (size_t)row * 1024 + tid * 4) = v;
  }
}

enum { K_PREP, K_E1A, K_E1, K_E2A, K_E2B, K_E2C, K_E2D, K_E3A, K_E3H13, K_E3H12, K_E3B, K_E4, K_RSA, K_M1, K_M2, K_RSB, K_O1, K_O2 , K_FINAL };
constexpr int NPHASE = 1 + 2 * (15 + 6) + 1;
__device__ __forceinline__ void phase_decode(int ph, int& kind, int& layer) {
  if (ph == 0) { kind = K_PREP; layer = 0; return; }
  if (ph == NPHASE - 1) { kind = K_FINAL; layer = 0; return; }
  int q = ph - 1;
  const int pair = q / 21; q -= pair * 21;
  if (q < 15) { layer = pair * 2; kind = K_E1A + q; }
  else { layer = pair * 2 + 1; q -= 15; kind = (q == 0) ? K_O1 : (q == 1) ? K_O2 : (q == 2) ? K_RSA : (q == 3) ? K_M1 : (q == 4) ? K_M2 : K_RSB; }
}

__device__ void run_phase(const Params& p, int ph, char* smem) {
  int kind, layer;
  phase_decode(ph, kind, layer);
  int G = gridDim.x; asm volatile("" : "+s"(G));
  const int bid = blockIdx.x;
  const int e = layer >> 1;
#ifdef ONLY_KIND
  if (kind != ONLY_KIND) return;
#endif
  switch (kind) {
    case K_PREP: phase_prep(p, smem); break;
    case K_E1A: for (int j = bid; j < 192; j += G) h2_job(p, e, j, smem); break;
    case K_E1: for (int j = bid; j < 11520; j += G) tile_win(p, e, j, smem); break;
    case K_E2A:
      for (int j = bid; j < 1024; j += G) filt_job<13>(p, e, j >> 9, j & 511, smem);
      for (int j = bid; j < 1024; j += G) filt_job<12>(p, e, j >> 9, j & 511, smem);
      break;
    case K_E2B: for (int j = bid; j < 3840; j += G) tile_uq(p, e, j, smem); break;
    case K_E2C: for (int j = bid; j < 5120; j += G) tile_ukv(p, e, j, smem); break;
    case K_E2D: for (int j = bid; j < 5120; j += G) ropek_job(p, j); break;
    case K_E3A:
      if (G == 512) {
        const int x = bid & 7, slot = bid >> 3;
        for (int r = 0; r < 8; ++r) attn_item(p, ((r * 8 + x) << 6) | slot, smem);
        for (int r = 0; r < 2; ++r) attn_item(p, 4096 + (((r * 16 + x * 2 + (slot >> 5)) << 5) | (slot & 31)), smem);
      } else {
        for (int j = bid; j < 5120; j += G) attn_item(p, j, smem);
      }
      break;
    case K_E3H13: for (int j = bid; j < 2048; j += G) hyena_job<13>(p, e, j >> 2, (j & 3) * 2, smem); break;
    case K_E3H12: for (int j = bid; j < 1024; j += G) hyena_job<12>(p, e, j >> 1, (j & 1) * 2, smem); break;
    case K_E3B: for (int j = bid; j < 10240; j += G) ztrans_item(p, j, smem); break;
    case K_E4: for (int j = bid; j < 5120; j += G) tile_wout(p, layer, j, smem); break;
    case K_M1: for (int j = bid; j < 640 * 32; j += G) tile_mlp1(p, layer, j, smem); break;
    case K_M2: for (int j = bid; j < 5120; j += G) tile_mlp2(p, layer, j, smem); break;
    case K_RSA: rs_rows(p, OFF_PARTA); break;
    case K_RSB: rs_rows(p, OFF_PARTB); break;
    case K_O1: for (int j = bid; j < NT / 2; j += G) pooldiff_job(p, layer, j); break;
    case K_O2: for (int j = bid; j < 5120; j += G) tile_pool(p, layer, j, smem); break;
    case K_FINAL: final_rows(p); break;
  }
}


#define XB_TMO      128
#define XB_XCNT(j)  (256  + 64 * (j))
#define XB_XSUB(j)  (1280 + 64 * (j))
#define XB_XGEN(j)  (2304 + 64 * (j))
#define XB_TOP      3328
#define XB_TOPGEN   3392
#define XCD_BAR_WORDS 3456
#define XB_SPIN_CAP (1u << 22)
#define XB_LAS __attribute__((address_space(3)))
__device__ __forceinline__ unsigned xb_ld(unsigned* q) { return __hip_atomic_load(q, __ATOMIC_RELAXED, __HIP_MEMORY_SCOPE_AGENT); }
__device__ __forceinline__ unsigned xb_add(unsigned* q, unsigned v) { return __hip_atomic_fetch_add(q, v, __ATOMIC_RELAXED, __HIP_MEMORY_SCOPE_AGENT); }
__device__ __forceinline__ unsigned xb_xcc_id() { return (unsigned)__builtin_amdgcn_s_getreg((3 << 11) | 20) & 0xFu; }
#define XB_SPIN(cond, bar) do { unsigned _sp = 0; while (cond) { __builtin_amdgcn_s_sleep(1); \
    if ((++_sp & 255u) == 0u) { if (xb_ld(&(bar)[XB_TMO])) break; if (_sp > XB_SPIN_CAP) { atomicAdd(&(bar)[XB_TMO], 1u); break; } } } } while (0)
struct XcdBarrier { unsigned* bar; unsigned x; volatile XB_LAS unsigned* st; };
__device__ __forceinline__ XcdBarrier xcd_barrier_post(unsigned* bar, volatile XB_LAS unsigned* st) {
  XcdBarrier b; b.bar = bar; b.x = xb_xcc_id(); b.st = st;
  if (threadIdx.x == 0) (void)xb_add(&bar[XB_XCNT(b.x)], 1u);
  return b;
}
__device__ __forceinline__ void xcd_barrier_complete(unsigned* bar, unsigned x, unsigned& nloc, unsigned& nx) {
  const unsigned G = gridDim.x * gridDim.y * gridDim.z;
  unsigned sum, cnt, mine, sp = 0u;
  for (;;) {
    sum = 0u; cnt = 0u; mine = 0u;
#pragma unroll
    for (unsigned j = 0; j < 16; ++j) { const unsigned c = xb_ld(&bar[XB_XCNT(j)]); sum += c; cnt += (c > 0u) ? 1u : 0u; mine = (j == x) ? c : mine; }
    if (sum == G) break;
    __builtin_amdgcn_s_sleep(1);
    if ((++sp & 255u) == 0u) { if (xb_ld(&bar[XB_TMO])) break; if (sp > XB_SPIN_CAP) { atomicAdd(&bar[XB_TMO], 1u); break; } }
  }
  nloc = mine > 0u ? mine : 1u; nx = cnt > 0u ? cnt : 1u;
}
__device__ __forceinline__ void xcd_barrier(const XcdBarrier& b) {
  asm volatile("s_waitcnt vmcnt(0)" ::: "memory");
  __syncthreads();
  if (threadIdx.x == 0) {
    unsigned* bar = b.bar;
    __builtin_amdgcn_s_waitcnt(0);
    unsigned nloc = b.st[0], nx = b.st[1];
    if (nloc == 0u) { xcd_barrier_complete(bar, b.x, nloc, nx); b.st[0] = nloc; b.st[1] = nx; }
    const unsigned old = xb_add(&bar[XB_XSUB(b.x)], 1u);
    const unsigned gen = old / nloc;
    if (old + 1u == (gen + 1u) * nloc) {
      __builtin_amdgcn_fence(__ATOMIC_RELEASE, "agent");
      asm volatile("s_waitcnt vmcnt(0)" ::: "memory");
      const unsigned og = xb_add(&bar[XB_TOP], 1u);
      const unsigned tg = og / nx;
      if (og + 1u == (tg + 1u) * nx) xb_add(&bar[XB_TOPGEN], 1u);
      else XB_SPIN(xb_ld(&bar[XB_TOPGEN]) == tg, bar);
      __builtin_amdgcn_fence(__ATOMIC_ACQUIRE, "agent");
      xb_add(&bar[XB_XGEN(b.x)], 1u);
      asm volatile("s_waitcnt vmcnt(0)" ::: "memory");
    } else {
      XB_SPIN(xb_ld(&bar[XB_XGEN(b.x)]) == gen, bar);
      __builtin_amdgcn_fence(__ATOMIC_ACQUIRE, "agent");
      asm volatile("s_waitcnt vmcnt(0)" ::: "memory");
    }
  }
  __syncthreads();
}

__global__ void __launch_bounds__(256, 2) mega(Params p, int ph_lo, int ph_hi, int coop) {
  __shared__ __attribute__((aligned(16))) char smem[SMEM_BYTES];
  __shared__ __attribute__((aligned(16))) unsigned xb_st[4];
  if (threadIdx.x < 4) xb_st[threadIdx.x] = 0u;
  __syncthreads();
  XcdBarrier xb = xcd_barrier_post((unsigned*)(p.ws + OFF_BAR), (volatile XB_LAS unsigned*)xb_st);
  for (int ph = ph_lo; ph < ph_hi; ++ph) {
    run_phase(p, ph, smem);
    if (coop && ph + 1 < ph_hi) {
      if (ph == ph_lo) cg::this_grid().sync();
      else xcd_barrier(xb);
    }
  }
}

extern "C" void kernel_launch(void* const* d_in, const int* in_sizes, int n_in, void* d_out, int out_size, void* d_ws,
                              size_t ws_size, hipStream_t stream) {
  (void)in_sizes; (void)n_in; (void)out_size;
  if (ws_size < WS_NEED) { fprintf(stderr, "workspace too small: %zu < %zu\n", ws_size, (size_t)WS_NEED); return; }
  Params p;
  memset(&p, 0, sizeof(p));
  const float** pp = (const float**)&p;
  for (int i = 0; i < 24; ++i) pp[i] = (const float*)d_in[i];
  p.out = (float*)d_out;
  p.ws = (char*)d_ws;
  u16* W = (u16*)((char*)d_ws + OFF_W);
  int nt = 0, tiles = 0;
  auto add = [&](const float* src, u16* dst, const float* gk, const float* gn, int K, int N, int Npad, int perm) {
    ConvTask& t = p.tasks[nt++];
    t.src = src; t.dst = dst; t.gk = gk; t.gn = gn; t.K = K; t.N = N; t.Npad = Npad; t.perm = perm; t.tile0 = tiles; t.pad = 0;
    tiles += (K / 64) * (Npad / 64);
  };
  for (int i = 0; i < 4; ++i) {
    add(p.mlp_w1 + (size_t)i * 1024 * 4096, W + WM1_O + (size_t)i * 4096 * 1024, p.mlp_norm + i * 1024, nullptr, 1024, 4096, 4096, 0);
    add(p.mlp_w2 + (size_t)i * 4096 * 1024, W + WM2_O + (size_t)i * 4096 * 1024, nullptr, nullptr, 4096, 1024, 1024, 0);
  }
  for (int e = 0; e < 2; ++e) {
    add(p.w_in + (size_t)e * 1024 * 2208, W + WIN_O + (size_t)e * 2304 * 1024, p.mix_norm + (2 * e) * 1024, nullptr, 1024, 2208, 2304, 0);
    add(p.w_uq + (size_t)e * 384 * 768, W + WUQ_O + (size_t)e * 768 * 384, p.q_norm + e * 384, nullptr, 384, 768, 768, 1);
    add(p.w_ukv + (size_t)e * 256 * 1024, W + WUKV_O + (size_t)e * 1024 * 256, p.kv_norm + e * 256, nullptr, 256, 1024, 1024, 0);
    add(p.w_out + (size_t)e * 1024 * 1024, W + WOUT_O + (size_t)e * 1024 * 1024, nullptr, nullptr, 1024, 1024, 1024, 0);
  }
  for (int o = 0; o < 2; ++o)
    for (int gi = 0; gi < 4; ++gi)
      add(p.pool_w + (size_t)(o * 4 + gi) * 65536, W + WPOOL_O + (size_t)(o * 4 + gi) * 65536,
          p.mix_norm + (2 * o + 1) * 1024 + gi * 256, p.pool_scale + o * 1024 + gi * 256, 256, 256, 256, 0);
  p.ntasks = nt; p.total_conv_tiles = tiles;

  static int grid_blocks = 0;
  if (!grid_blocks) {
    int dev = 0, cus = 0, per_cu = 0;
    hipGetDevice(&dev);
    hipDeviceGetAttribute(&cus, hipDeviceAttributeMultiprocessorCount, dev);
    hipOccupancyMaxActiveBlocksPerMultiprocessor(&per_cu, mega, 256, 0);
    if (per_cu < 1) per_cu = 1;
    grid_blocks = cus * per_cu;
    if (grid_blocks > MAX_GRID) grid_blocks = MAX_GRID;
  }
#if MULTI_LAUNCH
  for (int ph = 0; ph < NPHASE; ++ph) hipLaunchKernelGGL(mega, dim3(grid_blocks), dim3(256), 0, stream, p, ph, ph + 1, 0);
#else
  hipMemsetAsync((char*)d_ws + OFF_BAR, 0, XCD_BAR_WORDS * sizeof(unsigned), stream);
  int lo = 0, hi = NPHASE, coop = 1;
  void* args[] = {&p, &lo, &hi, &coop};
  hipError_t err = hipLaunchCooperativeKernel((void*)mega, dim3(grid_blocks), dim3(256), args, 0, stream);
  if (err != hipSuccess) fprintf(stderr, "cooperative launch failed: %s (grid %d)\n", hipGetErrorString(err), grid_blocks);
#endif
}
```

```cpp
#include <hip/hip_runtime.h>
#include <hip/hip_cooperative_groups.h>
#include <cstdio>
#include <cstring>
#include <cstdint>
namespace cg = cooperative_groups;

#ifndef MULTI_LAUNCH
#define MULTI_LAUNCH 0
#endif

typedef unsigned short u16;
typedef __attribute__((ext_vector_type(8))) short bf16x8;
typedef __attribute__((ext_vector_type(4))) short s16x4;
typedef __attribute__((ext_vector_type(4))) float f32x4;
typedef __attribute__((ext_vector_type(4))) unsigned u32x4;

constexpr int NT = 81920;
constexpr int TPR = 65536;
constexpr float EPS = 1e-6f;
constexpr size_t MiB = 1048576;

constexpr size_t OFF_W = 0;
constexpr size_t WIN_O = 0;
constexpr size_t WUQ_O = WIN_O + 2ull * 2304 * 1024;
constexpr size_t WUKV_O = WUQ_O + 2ull * 768 * 384;
constexpr size_t WOUT_O = WUKV_O + 2ull * 1024 * 256;
constexpr size_t WPOOL_O = WOUT_O + 2ull * 1024 * 1024;
constexpr size_t WM1_O = WPOOL_O + 8ull * 256 * 256;
constexpr size_t WM2_O = WM1_O + 4ull * 4096 * 1024;
constexpr size_t W_END = WM2_O + 4ull * 4096 * 1024;
static_assert(W_END * 2 <= 88 * MiB, "weights region");
constexpr size_t OFF_SMALL = 88 * MiB;
constexpr size_t SS_O = 0;
constexpr size_t SSQ_O = SS_O + 9ull * NT * 4;
constexpr size_t SSKV_O = SSQ_O + 2ull * NT * 4;
constexpr size_t ROPEC_O = SSKV_O + 2ull * NT * 4;
constexpr size_t ROPES_O = ROPEC_O + 8192ull * 16 * 4;
constexpr size_t H2_O = ROPES_O + 8192ull * 16 * 4;
constexpr size_t SMALL_END = H2_O + 12288ull * 64 * 4;
static_assert(SMALL_END <= 10 * MiB, "small region");
constexpr size_t OFF_XB = 98 * MiB;
constexpr size_t OFF_Q = 98 * MiB;
constexpr size_t OFF_K = 218 * MiB;
constexpr size_t OFF_KR = 298 * MiB;
constexpr size_t OFF_UT = 303 * MiB;
constexpr size_t OFF_D = 303 * MiB;
constexpr size_t OFF_VT = 543 * MiB;
constexpr size_t OFF_MIX = 623 * MiB;
constexpr size_t OFF_PQ = 623 * MiB;
constexpr size_t OFF_KF = 783 * MiB;
constexpr size_t OFF_YST = 975 * MiB;
constexpr size_t OFF_HID = 258 * MiB;
constexpr size_t OFF_PARTA = 1007 * MiB;
constexpr size_t OFF_PARTB = OFF_PARTA + (size_t)NT * 64;
constexpr size_t OFF_PQS = OFF_PARTB + (size_t)NT * 64;
constexpr size_t OFF_PKVS = OFF_PQS + (size_t)NT * 32;
constexpr size_t OFF_BAR = 1021 * MiB;
constexpr size_t WS_NEED = 1022 * MiB;
static_assert(OFF_PKVS + (size_t)NT * 16 <= WS_NEED, "ws");
constexpr int MAX_GRID = 512;

constexpr int SMEM_BYTES = 67584;
#define PADI(i) ((i) + ((i) >> 5))

struct ConvTask { const float* src; u16* dst; const float* gk; const float* gn; int K, N, Npad, perm, tile0, pad; };

struct Params {
  const float *x_prompt, *x_sample, *mix_norm, *w_in, *hy_conv_w, *hy_conv_b, *hf_w1, *hf_b1, *hf_freq, *hf_w2,
      *hf_b2, *hf_w3, *hy_bias, *q_norm, *w_uq, *kv_norm, *w_ukv, *w_out, *pool_w, *pool_scale, *mlp_norm, *mlp_w1,
      *mlp_w2, *final_norm;
  float* out;
  char* ws;
  ConvTask tasks[24];
  int ntasks, total_conv_tiles;
};

typedef __bf16 hwbf2 __attribute__((ext_vector_type(2)));
typedef float hwf2 __attribute__((ext_vector_type(2)));
__device__ __forceinline__ unsigned pack2(float a, float b) {
  const hwf2 v = {a, b};
  return __builtin_bit_cast(unsigned, __builtin_convertvector(v, hwbf2));
}
__device__ __forceinline__ u16 f2bf(float f) { return (u16)(pack2(f, 0.f) & 0xffffu); }
__device__ __forceinline__ float bf2f(u16 h) { return __uint_as_float(((unsigned)h) << 16); }
__device__ __forceinline__ float2 cmul(float2 a, float2 b) { return make_float2(a.x * b.x - a.y * b.y, a.x * b.y + a.y * b.x); }
__device__ __forceinline__ float2 cmulc(float2 a, float2 b) { return make_float2(a.x * b.x + a.y * b.y, a.y * b.x - a.x * b.y); }
__device__ __forceinline__ float2 twid(float rev) { return make_float2(__builtin_amdgcn_cosf(rev), -__builtin_amdgcn_sinf(rev)); }
__device__ __forceinline__ float sin_acc(float x) {
  double r = (double)x * 0.15915494309189533577;
  r -= floor(r);
  return __builtin_amdgcn_sinf((float)r);
}
__device__ __forceinline__ float cos_acc(float x) {
  double r = (double)x * 0.15915494309189533577;
  r -= floor(r);
  return __builtin_amdgcn_cosf((float)r);
}
__device__ __forceinline__ int ltid() { int t = threadIdx.x; asm volatile("" : "+v"(t)); return t; }
__device__ __forceinline__ char* lws(char* w) { asm volatile("" : "+s"(w)); return w; }
__device__ __forceinline__ float2 ld_l2(const float2* q) {
  const unsigned long long v = __hip_atomic_load((const unsigned long long*)q, __ATOMIC_RELAXED, __HIP_MEMORY_SCOPE_AGENT);
  return make_float2(__uint_as_float((unsigned)v), __uint_as_float((unsigned)(v >> 32)));
}
__device__ __forceinline__ u32x4 gload128(const void* q) {
  u32x4 v;
  asm volatile("global_load_dwordx4 %0, %1, off" : "=&v"(v) : "v"(q) : "memory");
  return v;
}
__device__ __forceinline__ void vm_wait0() { asm volatile("s_waitcnt vmcnt(0)" ::: "memory"); }
__device__ __forceinline__ int seq_pos(int row) { return row < TPR ? (row & 8191) : (row & 4095); }
__device__ __forceinline__ size_t ut_index(int row, int col) {
  if (row < TPR) { int b = row >> 13, t = row & 8191; return (((size_t)(b * 1536 + col)) << 13) + t; }
  int r = row - TPR; int b = r >> 12, t = r & 4095;
  return (size_t)TPR * 1536 + (((size_t)(b * 1536 + col)) << 12) + t;
}
__device__ __forceinline__ size_t vt_index(int row, int h, int d) {
  if (row < TPR) { int b = row >> 13, t = row & 8191; return (((size_t)((b * 8 + h) * 64 + d)) << 13) + t; }
  int r = row - TPR; int b = r >> 12, t = r & 4095;
  return (size_t)TPR * 512 + (((size_t)((b * 8 + h) * 64 + d)) << 12) + t;
}
__device__ __forceinline__ float row_rs16(const float* part, int row) {
  float s = 0.f;
#pragma unroll
  for (int i = 0; i < 8; ++i) s += part[(size_t)i * NT + row];
  return rsqrtf(s * (1.f / 1024.f) + EPS);
}
__device__ __forceinline__ float red16(float v) {
  v += __shfl_xor(v, 1); v += __shfl_xor(v, 2); v += __shfl_xor(v, 4); v += __shfl_xor(v, 8);
  return v;
}

#define G_LOAD(RA, RB, KT)                                                              \
  {                                                                                     \
    const int kc_ = ((KT) < nk) ? (KT) : (nk - 1);                                      \
    _Pragma("unroll") for (int i = 0; i < 4; ++i) {                                     \
      RA[i] = gload128(ap + (size_t)(32 * i) * lda + kc_ * 64);                         \
      RB[i] = gload128(bp + (size_t)(32 * i) * ldb + kc_ * 64);                         \
    }                                                                                   \
  }
#define G_STORE(RA, RB, BUF)                                                            \
  {                                                                                     \
    char* da_ = smem + (BUF) * 32768;                                                   \
    _Pragma("unroll") for (int i = 0; i < 4; ++i) {                                     \
      *(u32x4*)(da_ + soff + i * 4096) = RA[i];                                         \
      *(u32x4*)(da_ + 16384 + soff + i * 4096) = RB[i];                                 \
    }                                                                                   \
  }
#define G_COMPUTE(BUF)                                                                  \
  {                                                                                     \
    const char* sa = smem + (BUF) * 32768;                                              \
    const char* sb = sa + 16384;                                                        \
    _Pragma("unroll") for (int ks = 0; ks < 2; ++ks) {                                  \
      bf16x8 af[4], bfr[4];                                                             \
      const int coff = (((ks * 4 + g) ^ sw) << 4);                                      \
      _Pragma("unroll") for (int mi = 0; mi < 4; ++mi)                                  \
        af[mi] = *(const bf16x8*)(sa + (wr * 64 + mi * 16 + l15) * 128 + coff);         \
      _Pragma("unroll") for (int ni = 0; ni < 4; ++ni)                                  \
        bfr[ni] = *(const bf16x8*)(sb + (wc * 64 + ni * 16 + l15) * 128 + coff);        \
      __builtin_amdgcn_s_setprio(1);                                                    \
      _Pragma("unroll") for (int mi = 0; mi < 4; ++mi)                                  \
        _Pragma("unroll") for (int ni = 0; ni < 4; ++ni)                                \
          acc[mi][ni] = __builtin_amdgcn_mfma_f32_16x16x32_bf16(af[mi], bfr[ni], acc[mi][ni], 0, 0, 0); \
      __builtin_amdgcn_s_setprio(0);                                                    \
    }                                                                                   \
  }
__device__ __forceinline__ void vm_wait8() { asm volatile("s_waitcnt vmcnt(8)" ::: "memory"); }

__device__ __forceinline__ void gemm_core(const u16* __restrict__ A, int lda, const u16* __restrict__ B, int ldb, int K,
                                          char* smem, f32x4 (&acc)[4][4]) {
  const int tid = ltid(), lane = tid & 63, wave = tid >> 6, wr = wave >> 1, wc = wave & 1;
  const int lrow = tid >> 3, lch = tid & 7;
  const int l15 = lane & 15, g = lane >> 4;
  const u16* ap = A + (size_t)lrow * lda + lch * 8;
  const u16* bp = B + (size_t)lrow * ldb + lch * 8;
  const int soff = lrow * 128 + ((lch ^ ((lrow >> 1) & 7)) << 4);
  const int sw = (l15 >> 1) & 7;
  const int nk = K >> 6;
  u32x4 ra0[4], rb0[4], ra1[4], rb1[4];
  G_LOAD(ra0, rb0, 0);
  G_LOAD(ra1, rb1, 1);
#pragma unroll
  for (int mi = 0; mi < 4; ++mi)
#pragma unroll
    for (int ni = 0; ni < 4; ++ni) acc[mi][ni] = f32x4{0.f, 0.f, 0.f, 0.f};
  vm_wait8();
  G_STORE(ra0, rb0, 0);
  __syncthreads();
  for (int kt = 0; kt < nk; kt += 2) {
    G_LOAD(ra0, rb0, kt + 2);
    __builtin_amdgcn_sched_barrier(0);
    G_COMPUTE(0);
    __builtin_amdgcn_sched_barrier(0);
    vm_wait8();
    G_STORE(ra1, rb1, 1);
    __syncthreads();
    G_LOAD(ra1, rb1, kt + 3);
    __builtin_amdgcn_sched_barrier(0);
    G_COMPUTE(1);
    __builtin_amdgcn_sched_barrier(0);
    vm_wait8();
    G_STORE(ra0, rb0, 0);
    __syncthreads();
  }
  vm_wait0();
#pragma unroll
  for (int i = 0; i < 4; ++i) asm volatile("" :: "v"(ra1[i]), "v"(rb1[i]));
}

#define EPI_COORDS                                                                     \
  const int tid_e = ltid(); const int lane = tid_e & 63, wave = tid_e >> 6, wr = wave >> 1, wc = wave & 1; \
  const int l15 = lane & 15, g = lane >> 4;                                             \
  (void)wr; (void)wc; (void)l15; (void)g;

__device__ __forceinline__ void store_rows_bf16(const u16* st, int ldst, u16* dst, size_t ldd, int tid) {
#pragma unroll
  for (int i = 0; i < 8; ++i) {
    const int c = tid + 256 * i, rl = c >> 4, cc = c & 15;
    *(uint4*)(dst + (size_t)rl * ldd + cc * 8) = *(const uint4*)(st + rl * ldst + cc * 8);
  }
}

__device__ void tile_win(const Params& p, int e, int tile, char* smem) {
  const int mt = tile / 18, nt = tile % 18;
  const int m0 = mt * 128, n0 = nt * 128;
  const u16* A = (const u16*)(p.ws + OFF_XB) + (size_t)m0 * 1024;
  const u16* B = (const u16*)(p.ws + OFF_W) + WIN_O + (size_t)e * 2304 * 1024 + (size_t)n0 * 1024;
  f32x4 acc[4][4];
  gemm_core(A, 1024, B, 1024, 1024, smem, acc);
  EPI_COORDS
  const float* RSv = (const float*)(p.ws + OFF_SMALL + SS_O);
  float* pqs = (float*)(p.ws + OFF_PQS);
  float* pkvs = (float*)(p.ws + OFF_PKVS);
  u16* st = (u16*)smem;
  const int colbase = n0 + wc * 64;
#pragma unroll
  for (int mi = 0; mi < 4; ++mi) {
    const int rl0 = wr * 64 + mi * 16 + g * 4;
    const int r0 = m0 + rl0;
    float rs[4];
#pragma unroll
    for (int j = 0; j < 4; ++j) rs[j] = RSv[r0 + j];
    if (nt < 12) {
#pragma unroll
      for (int ni = 0; ni < 4; ++ni) {
        uint2 pk;
        pk.x = pack2(acc[mi][ni][0] * rs[0], acc[mi][ni][1] * rs[1]);
        pk.y = pack2(acc[mi][ni][2] * rs[2], acc[mi][ni][3] * rs[3]);
        *(uint2*)(st + (wc * 64 + ni * 16 + l15) * 136 + rl0) = pk;
      }
    } else {
      float sq[4] = {0.f, 0.f, 0.f, 0.f};
#pragma unroll
      for (int ni = 0; ni < 4; ++ni)
#pragma unroll
        for (int j = 0; j < 4; ++j) {
          const float v = acc[mi][ni][j] * rs[j];
          sq[j] += v * v;
          st[(rl0 + j) * 136 + wc * 64 + ni * 16 + l15] = f2bf(v);
        }
      if (colbase < 2176) {
#pragma unroll
        for (int j = 0; j < 4; ++j) {
          float sm_ = red16(sq[j]);
          if (l15 == 0) {
            if (colbase < 1920) pqs[((size_t)(nt - 12) * NT + (r0 + j)) * 2 + wc] = sm_;
            else pkvs[((size_t)(nt - 15) * NT + (r0 + j)) * 2 + wc] = sm_;
          }
        }
      }
    }
  }
  __syncthreads();
  if (nt < 12) {
    u16* Ut = (u16*)(p.ws + OFF_UT);
#pragma unroll
    for (int i = 0; i < 8; ++i) {
      const int c = tid_e + 256 * i, cl = c >> 4, rc = c & 15;
      *(uint4*)(Ut + ut_index(m0 + rc * 8, n0 + cl)) = *(const uint4*)(st + cl * 136 + rc * 8);
    }
  } else {
    store_rows_bf16(st, 136, (u16*)(p.ws + OFF_PQ) + (size_t)m0 * 768 + (n0 - 1536), 768, tid_e);
  }
  __syncthreads();
}

__device__ void tile_uq(const Params& p, int e, int tile, char* smem) {
  const int mt = tile / 6, nt = tile % 6;
  const int m0 = mt * 128, n0 = nt * 128;
  const u16* A = (const u16*)(p.ws + OFF_PQ) + (size_t)m0 * 768;
  const u16* B = (const u16*)(p.ws + OFF_W) + WUQ_O + (size_t)e * 768 * 384 + (size_t)n0 * 384;
  f32x4 acc[4][4];
  gemm_core(A, 768, B, 384, 384, smem, acc);
  EPI_COORDS
  const float* pqs = (const float*)(p.ws + OFF_PQS);
  const float* rc = (const float*)(p.ws + OFF_SMALL + ROPEC_O);
  const float* rsn = (const float*)(p.ws + OFF_SMALL + ROPES_O);
  u16* st = (u16*)smem;
  const float qscale = 0.10206207261596577f * 1.4426950408889634f;
#pragma unroll
  for (int mi = 0; mi < 4; ++mi) {
    const int rl0 = wr * 64 + mi * 16 + g * 4;
#pragma unroll
    for (int j = 0; j < 4; ++j) {
      const int rl = rl0 + j, row = m0 + rl;
      const float2 qa = *(const float2*)(pqs + (size_t)row * 2), qb2 = *(const float2*)(pqs + ((size_t)NT + row) * 2), qc = *(const float2*)(pqs + ((size_t)2 * NT + row) * 2);
      const float rs = rsqrtf((((qa.x + qa.y) + (qb2.x + qb2.y)) + (qc.x + qc.y)) * (1.f / 384.f) + EPS) * qscale;
      if (nt < 4) {
#pragma unroll
        for (int ni = 0; ni < 4; ++ni) st[rl * 136 + wc * 64 + ni * 16 + l15] = f2bf(acc[mi][ni][j] * rs);
      } else {
        const int pos = seq_pos(row);
        const float c = rc[pos * 16 + l15], sn = rsn[pos * 16 + l15];
#pragma unroll
        for (int pp = 0; pp < 2; ++pp) {
          const float x1 = acc[mi][2 * pp][j] * rs, x2 = acc[mi][2 * pp + 1][j] * rs;
          st[rl * 136 + (wc * 2 + pp) * 32 + l15] = f2bf(x1 * c - x2 * sn);
          st[rl * 136 + (wc * 2 + pp) * 32 + 16 + l15] = f2bf(x1 * sn + x2 * c);
        }
      }
    }
  }
  __syncthreads();
  u16* Qn = (u16*)(p.ws + OFF_Q);
  u16* Qr = Qn + (size_t)NT * 512;
  if (nt < 4) store_rows_bf16(st, 136, Qn + (size_t)m0 * 512 + n0, 512, tid_e);
  else store_rows_bf16(st, 136, Qr + (size_t)m0 * 256 + (nt - 4) * 128, 256, tid_e);
  __syncthreads();
}

__device__ void tile_ukv(const Params& p, int e, int tile, char* smem) {
  const int mt = tile >> 3, h = tile & 7;
  const int m0 = mt * 128, n0 = h * 128;
  const u16* A = (const u16*)(p.ws + OFF_PQ) + (size_t)m0 * 768 + 384;
  const u16* B = (const u16*)(p.ws + OFF_W) + WUKV_O + (size_t)e * 1024 * 256 + (size_t)n0 * 256;
  f32x4 acc[4][4];
  gemm_core(A, 768, B, 256, 256, smem, acc);
  EPI_COORDS
  const float* pkvs = (const float*)(p.ws + OFF_PKVS);
  u16* stK = (u16*)smem;
  u16* stV = (u16*)(smem + 18432);
#pragma unroll
  for (int mi = 0; mi < 4; ++mi) {
    const int rl0 = wr * 64 + mi * 16 + g * 4;
    const int r0 = m0 + rl0;
    float rs[4];
#pragma unroll
    for (int j = 0; j < 4; ++j) { const float2 ka = *(const float2*)(pkvs + (size_t)(r0 + j) * 2), kb2 = *(const float2*)(pkvs + ((size_t)NT + r0 + j) * 2); rs[j] = rsqrtf(((ka.x + ka.y) + (kb2.x + kb2.y)) * (1.f / 256.f) + EPS); }
    if (wc == 0) {
#pragma unroll
      for (int ni = 0; ni < 4; ++ni)
#pragma unroll
        for (int j = 0; j < 4; ++j) stK[(rl0 + j) * 72 + ni * 16 + l15] = f2bf(acc[mi][ni][j] * rs[j]);
    } else {
#pragma unroll
      for (int ni = 0; ni < 4; ++ni) {
        uint2 pk;
        pk.x = pack2(acc[mi][ni][0] * rs[0], acc[mi][ni][1] * rs[1]);
        pk.y = pack2(acc[mi][ni][2] * rs[2], acc[mi][ni][3] * rs[3]);
        *(uint2*)(stV + (ni * 16 + l15) * 136 + rl0) = pk;
      }
    }
  }
  __syncthreads();
  u16* Kb = (u16*)(p.ws + OFF_K);
  u16* Vt = (u16*)(p.ws + OFF_VT);
#pragma unroll
  for (int i = 0; i < 4; ++i) {
    const int c = tid_e + 256 * i;
    { const int rl = c >> 3, cc = c & 7;
      *(uint4*)(Kb + (size_t)(m0 + rl) * 512 + h * 64 + cc * 8) = *(const uint4*)(stK + rl * 72 + cc * 8); }
    { const int d = c >> 4, rcx = c & 15;
      *(uint4*)(Vt + vt_index(m0 + rcx * 8, h, d)) = *(const uint4*)(stV + d * 136 + rcx * 8); }
  }
  __syncthreads();
}

__device__ __forceinline__ void epi_res(const Params& p, f32x4 (&acc)[4][4], int m0, int n0, const float* srcp,
                                        const float* srcs, float* ssn, char* smem) {
  EPI_COORDS
  float* st = (float*)smem;
#pragma unroll
  for (int mi = 0; mi < 4; ++mi)
#pragma unroll
    for (int ni = 0; ni < 4; ++ni)
#pragma unroll
      for (int j = 0; j < 4; ++j) st[(wr * 64 + mi * 16 + g * 4 + j) * 132 + wc * 64 + ni * 16 + l15] = acc[mi][ni][j];
  __syncthreads();
  u16* xb = (u16*)(p.ws + OFF_XB);
  const int cc = tid_e & 31, r8 = tid_e >> 5;
#pragma unroll 4
  for (int i = 0; i < 16; ++i) {
    const int rl = i * 8 + r8;
    const int row = m0 + rl;
    const float4 d = *(const float4*)(st + rl * 132 + cc * 4);
    const float* xin = (row < TPR) ? (srcp + (size_t)row * 1024) : (srcs + (size_t)(row - TPR) * 1024);
    const float4 x = *(const float4*)(xin + n0 + cc * 4);
    float4 xn; xn.x = x.x + d.x; xn.y = x.y + d.y; xn.z = x.z + d.z; xn.w = x.w + d.w;
    *(float4*)(p.out + (size_t)row * 1024 + n0 + cc * 4) = xn;
    uint2 pk; pk.x = pack2(xn.x, xn.y); pk.y = pack2(xn.z, xn.w);
    *(uint2*)(xb + (size_t)row * 1024 + n0 + cc * 4) = pk;
    float sq = xn.x * xn.x + xn.y * xn.y + xn.z * xn.z + xn.w * xn.w;
    sq += __shfl_xor(sq, 1); sq += __shfl_xor(sq, 2); sq += __shfl_xor(sq, 4); sq += __shfl_xor(sq, 8); sq += __shfl_xor(sq, 16);
    if (cc == 0) ssn[(size_t)(n0 >> 7) * NT + row] = sq;
  }
  __syncthreads();
}

__device__ void tile_wout(const Params& p, int layer, int tile, char* smem) {
  const int e = layer >> 1;
  const int mt = tile >> 3, nt = tile & 7;
  const int m0 = mt * 128, n0 = nt * 128;
  const u16* A = (const u16*)(p.ws + OFF_MIX) + (size_t)m0 * 1024;
  const u16* B = (const u16*)(p.ws + OFF_W) + WOUT_O + (size_t)e * 1024 * 1024 + (size_t)n0 * 1024;
  f32x4 acc[4][4];
  gemm_core(A, 1024, B, 1024, 1024, smem, acc);
  const float* sp = (layer == 0) ? p.x_prompt : p.out;
  const float* ssrc = (layer == 0) ? p.x_sample : (p.out + (size_t)TPR * 1024);
  epi_res(p, acc, m0, n0, sp, ssrc, (float*)(p.ws + OFF_PARTA), smem);
}

__device__ void tile_pool(const Params& p, int layer, int tile, char* smem) {
  const int o = layer >> 1;
  const int mt = tile >> 3, nt = tile & 7, gi = nt >> 1;
  const int m0 = mt * 128, n0 = nt * 128;
  const u16* A = (const u16*)(p.ws + OFF_D) + (size_t)m0 * 1024 + gi * 256;
  const u16* B = (const u16*)(p.ws + OFF_W) + WPOOL_O + (size_t)(o * 4 + gi) * 65536 + (size_t)(nt & 1) * 128 * 256;
  f32x4 acc[4][4];
  gemm_core(A, 1024, B, 256, 256, smem, acc);
  epi_res(p, acc, m0, n0, p.out, p.out + (size_t)TPR * 1024, (float*)(p.ws + OFF_PARTA), smem);
}

__device__ void tile_mlp1(const Params& p, int layer, int tile, char* smem) {
  (void)layer;
  const int mt = tile >> 5, nt = tile & 31;
  const int m0 = mt * 128, n0 = nt * 128;
  const u16* A = (const u16*)(p.ws + OFF_XB) + (size_t)m0 * 1024;
  const u16* B = (const u16*)(p.ws + OFF_W) + WM1_O + (size_t)layer * 4096 * 1024 + (size_t)n0 * 1024;
  f32x4 acc[4][4];
  gemm_core(A, 1024, B, 1024, 1024, smem, acc);
  EPI_COORDS
  const float* RSv = (const float*)(p.ws + OFF_SMALL + SS_O);
  u16* st = (u16*)smem;
#pragma unroll
  for (int mi = 0; mi < 4; ++mi) {
    const int rl0 = wr * 64 + mi * 16 + g * 4;
#pragma unroll
    for (int j = 0; j < 4; ++j) {
      const float rs = RSv[m0 + rl0 + j];
#pragma unroll
      for (int ni = 0; ni < 4; ++ni) {
        const float v = fmaxf(acc[mi][ni][j] * rs, 0.f);
        st[(rl0 + j) * 136 + wc * 64 + ni * 16 + l15] = f2bf(v * v);
      }
    }
  }
  __syncthreads();
  u16* Hd = (u16*)(p.ws + OFF_HID);
#pragma unroll
  for (int i = 0; i < 8; ++i) {
    const int c = tid_e + 256 * i, rl = c >> 4, cc = c & 15;
    const uint4 v = *(const uint4*)(st + rl * 136 + cc * 8);
    *(uint4*)(Hd + (size_t)(m0 + rl) * 4096 + n0 + cc * 8) = v;
  }
  __syncthreads();
}

__device__ void tile_mlp2(const Params& p, int layer, int tile, char* smem) {
  const int mt = tile >> 3, nt = tile & 7;
  const int m0 = mt * 128, n0 = nt * 128;
  const u16* A = (const u16*)(p.ws + OFF_HID) + (size_t)m0 * 4096;
  const u16* B = (const u16*)(p.ws + OFF_W) + WM2_O + (size_t)layer * 4096 * 1024 + (size_t)n0 * 4096;
  f32x4 acc[4][4];
  gemm_core(A, 4096, B, 4096, 4096, smem, acc);
  epi_res(p, acc, m0, n0, p.out, p.out + (size_t)TPR * 1024, (float*)(p.ws + OFF_PARTB), smem);
}

__device__ void conv_tile(const ConvTask& t, int tile, char* smem) {
  float* sm = (float*)smem;
  const int nkt = t.K >> 6;
  const int kt = tile % nkt, nt = tile / nkt;
  const int tid = ltid();
  {
    const int nn = tid & 63, k4 = tid >> 6;
    const int np = nt * 64 + nn;
    int ns = np;
    if (t.perm) ns = (np < 512) ? ((np >> 6) * 96 + (np & 63)) : (((np - 512) >> 5) * 96 + 64 + ((np - 512) & 31));
    const float gn = (t.gn && np < t.N) ? t.gn[ns] : 1.f;
#pragma unroll
    for (int r = 0; r < 16; ++r) {
      const int kk = k4 + 4 * r;
      const int k = kt * 64 + kk;
      float v = 0.f;
      if (np < t.N) {
        v = t.src[(size_t)k * t.N + ns] * gn;
        if (t.gk) v *= t.gk[k];
      }
      sm[kk * 65 + nn] = v;
    }
  }
  __syncthreads();
  {
    const int kk = tid & 63, n4 = tid >> 6;
#pragma unroll
    for (int r = 0; r < 16; ++r) {
      const int nn = n4 + 4 * r;
      t.dst[(size_t)(nt * 64 + nn) * t.K + kt * 64 + kk] = f2bf(sm[kk * 65 + nn]);
    }
  }
  __syncthreads();
}

__device__ void phase_prep(const Params& p, char* smem) {
  int G = gridDim.x; asm volatile("" : "+s"(G));
  const int bid = blockIdx.x, tid = ltid();
  for (int tile = bid; tile < p.total_conv_tiles; tile += G) {
    int ti = 0;
    for (int i = 1; i < p.ntasks; ++i)
      if (tile >= p.tasks[i].tile0) ti = i;
    conv_tile(p.tasks[ti], tile - p.tasks[ti].tile0, smem);
  }
#ifdef ZERO_WS
  {
    uint4* z = (uint4*)(p.ws + 258 * MiB);
    const size_t n = (size_t)(1007 - 258) * MiB / 16;
    for (size_t i = (size_t)bid * 256 + tid; i < n; i += (size_t)G * 256) z[i] = make_uint4(0u, 0u, 0u, 0u);
  }
#endif
  {
    float* rc = (float*)(p.ws + OFF_SMALL + ROPEC_O);
    float* rsn = (float*)(p.ws + OFF_SMALL + ROPES_O);
    for (int i = bid * 256 + tid; i < 8192 * 16; i += G * 256) {
      const int pos = i >> 4, j = i & 15;
      const float inv_freq = 1.0f / powf(10000.f, (float)(2 * j) / 32.f);
      const float ang = (float)pos * inv_freq;
      rc[i] = cos_acc(ang);
      rsn[i] = sin_acc(ang);
    }
  }
  {
    u16* xb = (u16*)(p.ws + OFF_XB);
    float* RSw = (float*)(p.ws + OFF_SMALL + SS_O);
    const int lane = tid & 63, wave = tid >> 6;
    for (int rr = bid * 16 + wave * 4; rr < NT; rr += G * 16)
    for (int row = rr; row < rr + 4; ++row) {
      const float* xr = (row < TPR) ? (p.x_prompt + (size_t)row * 1024) : (p.x_sample + (size_t)(row - TPR) * 1024);
      float sq = 0.f;
#pragma unroll
      for (int i = 0; i < 4; ++i) {
        const float4 v = *(const float4*)(xr + i * 256 + lane * 4);
        sq += v.x * v.x + v.y * v.y + v.z * v.z + v.w * v.w;
        uint2 pk; pk.x = pack2(v.x, v.y); pk.y = pack2(v.z, v.w);
        *(uint2*)(xb + (size_t)row * 1024 + i * 256 + lane * 4) = pk;
      }
      sq += __shfl_xor(sq, 1); sq += __shfl_xor(sq, 2); sq += __shfl_xor(sq, 4);
      sq += __shfl_xor(sq, 8); sq += __shfl_xor(sq, 16); sq += __shfl_xor(sq, 32);
      if (lane == 0) RSw[row] = rsqrtf(sq * (1.f / 1024.f) + EPS);
    }
  }
}

__device__ void h2_job(const Params& p, int e, int job, char* smem) {
  float* zs = (float*)smem;
  float* h1s = zs + 4 * 36;
  const int tid = ltid(), u = tid & 63, tq = tid >> 6;
  int L, tbase; float* H2;
  if (job < 128) { L = 8192; tbase = job * 64; H2 = (float*)(p.ws + OFF_SMALL + H2_O); }
  else { L = 4096; tbase = (job - 128) * 64; H2 = (float*)(p.ws + OFF_SMALL + H2_O) + 8192 * 64; }
  const float* w1 = p.hf_w1 + (size_t)e * 33 * 64;
  const float* w2 = p.hf_w2 + (size_t)e * 64 * 64;
  const float b1 = p.hf_b1[e * 64 + u], b2 = p.hf_b2[e * 64 + u], fr = p.hf_freq[e * 64 + u];
  for (int it = 0; it < 16; ++it) {
    const int t = tbase + it * 4 + tq;
    if (u < 33) {
      float z;
      if (u == 0) z = (float)t / (float)(L - 1);
      else {
        const int j = (u - 1) & 15;
        const float band = 1e-4f + (float)j * ((15.f - 1e-4f) / 15.f);
        const float wpos = (6.283185307179586f / (float)L) * (float)t;
        const float ang = band * wpos;
        z = (u <= 16) ? cos_acc(ang) : -sin_acc(ang);
      }
      zs[tq * 36 + u] = z;
    }
    __syncthreads();
    float a = b1;
#pragma unroll
    for (int i = 0; i < 33; ++i) a += zs[tq * 36 + i] * w1[i * 64 + u];
    h1s[tq * 64 + u] = sin_acc(fr * a);
    __syncthreads();
    float a2 = b2;
#pragma unroll 8
    for (int i = 0; i < 64; ++i) a2 += h1s[tq * 64 + i] * w2[i * 64 + u];
    H2[(size_t)t * 64 + u] = sin_acc(fr * a2);
    __syncthreads();
  }
}

__device__ __forceinline__ float2 w16c(int k) {
  switch (k) {
    case 0: return make_float2(1.f, 0.f);
    case 1: return make_float2(0.9238795325112867f, -0.3826834323650898f);
    case 2: return make_float2(0.7071067811865476f, -0.7071067811865476f);
    case 3: return make_float2(0.3826834323650898f, -0.9238795325112867f);
    case 4: return make_float2(0.f, -1.f);
    case 5: return make_float2(-0.3826834323650898f, -0.9238795325112867f);
    case 6: return make_float2(-0.7071067811865476f, -0.7071067811865476f);
    default: return make_float2(-0.9238795325112867f, -0.3826834323650898f);
  }
}

template <int R, int HALF, bool INV, bool HASW>
__device__ __forceinline__ void fft_stage(float2 (&x)[R], const float2 wk) {
#pragma unroll
  for (int bs = 0; bs < R; bs += 2 * HALF) {
#pragma unroll
    for (int jj = 0; jj < HALF; ++jj) {
      const float2 c = w16c(jj * 8 / HALF);
      float2 t;
      if (HASW) t = (jj == 0) ? wk : cmul(wk, c); else t = c;
      const float2 a = x[bs + jj];
      if (!INV) {
        const float2 b = x[bs + jj + HALF];
        const float2 d = make_float2(a.x - b.x, a.y - b.y);
        x[bs + jj] = make_float2(a.x + b.x, a.y + b.y);
        x[bs + jj + HALF] = (!HASW && jj == 0) ? d : cmul(d, t);
      } else {
        const float2 b = (!HASW && jj == 0) ? x[bs + jj + HALF] : cmulc(x[bs + jj + HALF], t);
        x[bs + jj] = make_float2(a.x + b.x, a.y + b.y);
        x[bs + jj + HALF] = make_float2(a.x - b.x, a.y - b.y);
      }
    }
  }
}

template <int LOGR, int SLOG, bool INV, int LOGL>
__device__ __forceinline__ void fft_pass(float2* buf) {
  constexpr int R = 1 << LOGR, S = 1 << SLOG, L = 1 << LOGL, NB = L / R;
  constexpr bool HASW = (SLOG > 0);
  const int tid_f = ltid();
#pragma unroll 1
  for (int q = tid_f; q < NB; q += 256) {
    const int lo = q & (S - 1), hi = q >> SLOG;
    const int base = (hi << (SLOG + LOGR)) + lo;
    float2 x[R];
#pragma unroll
    for (int j = 0; j < R; ++j) x[j] = buf[PADI(base + j * S)];
    float2 w1 = make_float2(1.f, 0.f);
    if (HASW) w1 = twid((float)lo * (1.f / (float)(R * S)));
    const float2 w2 = cmul(w1, w1), w4 = cmul(w2, w2), w8 = cmul(w4, w4);
    if (R == 16) {
      if (!INV) { fft_stage<R, R / 2, INV, HASW>(x, w1); fft_stage<R, R / 4, INV, HASW>(x, w2); fft_stage<R, R / 8, INV, HASW>(x, w4); fft_stage<R, (R >= 16 ? R / 16 : 1), INV, HASW>(x, w8); }
      else { fft_stage<R, (R >= 16 ? R / 16 : 1), INV, HASW>(x, w8); fft_stage<R, R / 8, INV, HASW>(x, w4); fft_stage<R, R / 4, INV, HASW>(x, w2); fft_stage<R, R / 2, INV, HASW>(x, w1); }
    } else {
      if (!INV) { fft_stage<R, R / 2, INV, HASW>(x, w1); fft_stage<R, R / 4, INV, HASW>(x, w2); fft_stage<R, R / 8, INV, HASW>(x, w4); }
      else { fft_stage<R, R / 8, INV, HASW>(x, w4); fft_stage<R, R / 4, INV, HASW>(x, w2); fft_stage<R, R / 2, INV, HASW>(x, w1); }
    }
#pragma unroll
    for (int j = 0; j < R; ++j) buf[PADI(base + j * S)] = x[j];
  }
  __syncthreads();
}

template <int LOGL> __device__ __forceinline__ void fft_fwd(float2* buf) {
  if (LOGL == 13) {
    fft_pass<4, 9, false, LOGL>(buf); fft_pass<3, 6, false, LOGL>(buf); fft_pass<3, 3, false, LOGL>(buf); fft_pass<3, 0, false, LOGL>(buf);
  } else {
    fft_pass<3, 9, false, LOGL>(buf); fft_pass<3, 6, false, LOGL>(buf); fft_pass<3, 3, false, LOGL>(buf); fft_pass<3, 0, false, LOGL>(buf);
  }
}
template <int LOGL> __device__ __forceinline__ void fft_inv(float2* buf) {
  if (LOGL == 13) {
    fft_pass<3, 0, true, LOGL>(buf); fft_pass<3, 3, true, LOGL>(buf); fft_pass<3, 6, true, LOGL>(buf); fft_pass<4, 9, true, LOGL>(buf);
  } else {
    fft_pass<3, 0, true, LOGL>(buf); fft_pass<3, 3, true, LOGL>(buf); fft_pass<3, 6, true, LOGL>(buf); fft_pass<3, 9, true, LOGL>(buf);
  }
}

template <int LOGL> __device__ __forceinline__ void fft_fwd_head(float2* buf) {
  if (LOGL == 13) { fft_pass<4, 9, false, LOGL>(buf); fft_pass<3, 6, false, LOGL>(buf); fft_pass<3, 3, false, LOGL>(buf); }
  else { fft_pass<3, 9, false, LOGL>(buf); fft_pass<3, 6, false, LOGL>(buf); fft_pass<3, 3, false, LOGL>(buf); }
}
template <int LOGL> __device__ __forceinline__ void fft_inv_tail(float2* buf) {
  if (LOGL == 13) { fft_pass<3, 3, true, LOGL>(buf); fft_pass<3, 6, true, LOGL>(buf); fft_pass<4, 9, true, LOGL>(buf); }
  else { fft_pass<3, 3, true, LOGL>(buf); fft_pass<3, 6, true, LOGL>(buf); fft_pass<3, 9, true, LOGL>(buf); }
}
template <int LOGL> __device__ __forceinline__ void fft_mid(float2* buf, const float2* __restrict__ Kf) {
  constexpr int L = 1 << LOGL, NB = L / 8;
  const int tid_f = ltid();
#pragma unroll 1
  for (int q = tid_f; q < NB; q += 256) {
    const int base = q << 3;
    float2 x[8], k[8];
#pragma unroll
    for (int j = 0; j < 8; ++j) x[j] = buf[PADI(base) + j];
    {
      const float4 k0 = *(const float4*)(Kf + base), k1 = *(const float4*)(Kf + base + 2);
      const float4 k2 = *(const float4*)(Kf + base + 4), k3 = *(const float4*)(Kf + base + 6);
      k[0] = make_float2(k0.x, k0.y); k[1] = make_float2(k0.z, k0.w); k[2] = make_float2(k1.x, k1.y); k[3] = make_float2(k1.z, k1.w);
      k[4] = make_float2(k2.x, k2.y); k[5] = make_float2(k2.z, k2.w); k[6] = make_float2(k3.x, k3.y); k[7] = make_float2(k3.z, k3.w);
    }
    const float2 one = make_float2(1.f, 0.f);
    fft_stage<8, 4, false, false>(x, one); fft_stage<8, 2, false, false>(x, one); fft_stage<8, 1, false, false>(x, one);
#pragma unroll
    for (int j = 0; j < 8; ++j) x[j] = cmul(x[j], k[j]);
    fft_stage<8, 1, true, false>(x, one); fft_stage<8, 2, true, false>(x, one); fft_stage<8, 4, true, false>(x, one);
#pragma unroll
    for (int j = 0; j < 8; ++j) buf[PADI(base) + j] = x[j];
  }
  __syncthreads();
}

template <int LOGL> __device__ __forceinline__ float2* kf_ptr(const Params& p, int filt, int c, int half) {
  float2* base = (float2*)(p.ws + OFF_KF);
  if (LOGL == 12) base += (size_t)2 * 512 * 2 * 8192;
  return base + ((size_t)((filt * 512 + c) * 2 + half) << LOGL);
}

template <int LOGL> __device__ void filt_job(const Params& p, int e, int filt, int c, char* smem) {
  constexpr int L = 1 << LOGL, NE = L / 256;
  float2* buf = (float2*)smem;
  float* w3s = (float*)(smem + SMEM_BYTES - 512);
  const int tid = ltid();
  const float* H2 = (const float*)(p.ws + OFF_SMALL + H2_O) + (LOGL == 12 ? 8192 * 64 : 0);
  const float* w3 = p.hf_w3 + (size_t)e * 64 * 2048;
  if (tid < 128) {
    const int dir = tid >> 6, u = tid & 63;
    w3s[tid] = w3[(size_t)u * 2048 + dir * 1024 + filt * 512 + c];
  }
  __syncthreads();
  const float min_decay = -3.0701134573253945f, max_decay = -15.350567286626972f;
  const float delta = fabsf(min_decay + (max_decay - min_decay) * ((float)c / 511.f));
  {
    const int lane = tid & 63, wave = tid >> 6, rl = lane >> 2, q4 = lane & 3;
    constexpr int NIT = L / 64;
#pragma unroll 2
    for (int it = 0; it < NIT; ++it) {
      const int t = it * 64 + wave * 16 + rl;
      const float4* hr = (const float4*)(H2 + (size_t)t * 64 + q4 * 16);
      float af = 0.f, ab = 0.f;
#pragma unroll
      for (int q = 0; q < 4; ++q) {
        const float4 h = hr[q];
        const float* wf = w3s + q4 * 16 + q * 4;
        af += h.x * wf[0] + h.y * wf[1] + h.z * wf[2] + h.w * wf[3];
        ab += h.x * wf[64] + h.y * wf[65] + h.z * wf[66] + h.w * wf[67];
      }
      af += __shfl_xor(af, 1); ab += __shfl_xor(ab, 1);
      af += __shfl_xor(af, 2); ab += __shfl_xor(ab, 2);
      const float tl = (float)t / (float)(L - 1);
      const float dec = __expf(-tl * delta);
      if (it == NIT - 1) __syncthreads();
      if (q4 == 0) buf[PADI(t)] = make_float2(af * dec, ab * dec);
    }
  }
  __syncthreads();
  float2* dstE = kf_ptr<LOGL>(p, filt, c, 0);
  float2* dstO = kf_ptr<LOGL>(p, filt, c, 1);
#pragma unroll 2
  for (int i = 0; i < NE / 2; ++i) {
    const int u = tid + 256 * i;
    const int t0 = u, t1 = (u == 0) ? (L / 2) : (L - u);
    const float2 e0 = buf[PADI(t0)], e1 = buf[PADI(t1)];
    const float a0 = e0.x, b0 = (u == 0) ? 0.f : e1.y;
    const float a1 = e1.x, b1f = (u == 0) ? e1.y : e0.y;
    const float2 w0 = twid((float)t0 * (1.f / (float)(2 * L))), w1 = twid((float)t1 * (1.f / (float)(2 * L)));
    const float d0 = a0 - b0, d1 = a1 - b1f;
    dstO[t0] = make_float2(d0 * w0.x, d0 * w0.y);
    dstO[t1] = make_float2(d1 * w1.x, d1 * w1.y);
    buf[PADI(t0)] = make_float2(a0 + b0, 0.f);
    buf[PADI(t1)] = make_float2(a1 + b1f, 0.f);
  }
  __syncthreads();
  fft_fwd<LOGL>(buf);
  const float nrm = 1.f / (float)(2 * L);
#pragma unroll 4
  for (int i = 0; i < NE; ++i) { const float2 v = buf[PADI(tid + 256 * i)]; dstE[tid + 256 * i] = make_float2(v.x * nrm, v.y * nrm); }
  __syncthreads();
#pragma unroll 2
  for (int i = 0; i < NE / 2; ++i) {
    const int u = tid + 256 * i;
    const int t0 = u, t1 = (u == 0) ? (L / 2) : (L - u);
    buf[PADI(t0)] = dstO[t0];
    buf[PADI(t1)] = dstO[t1];
  }
  __syncthreads();
  fft_fwd<LOGL>(buf);
#pragma unroll 4
  for (int i = 0; i < NE; ++i) { const float2 v = buf[PADI(tid + 256 * i)]; dstO[tid + 256 * i] = make_float2(v.x * nrm, v.y * nrm); }
  __syncthreads();
}

__device__ __forceinline__ void short_conv4(const u16* u, int t, int L, float w0, float w1, float w2, float bias, float (&o)[4]) {
  const uint2 mid = *(const uint2*)(u + t);
  const int tm = (t > 0) ? t - 1 : 0, tp = (t + 4 < L) ? t + 4 : L - 1;
  const float vm = bf2f(u[tm]), vp = bf2f(u[tp]);
  const float um = (t > 0) ? vm : 0.f, up = (t + 4 < L) ? vp : 0.f;
  const float u0 = __uint_as_float(mid.x << 16), u1 = __uint_as_float(mid.x & 0xffff0000u);
  const float u2 = __uint_as_float(mid.y << 16), u3 = __uint_as_float(mid.y & 0xffff0000u);
  o[0] = w0 * um + w1 * u0 + w2 * u1 + bias;
  o[1] = w0 * u0 + w1 * u1 + w2 * u2 + bias;
  o[2] = w0 * u1 + w1 * u2 + w2 * u3 + bias;
  o[3] = w0 * u2 + w1 * u3 + w2 * up + bias;
}

struct HyCtx { u16* base; float w0, w1, w2, bs; const float2* zin; };
template <int LOGL> __device__ __forceinline__ float2* hy_zptr(u16* base, int t) {
  constexpr int L = 1 << LOGL;
  const int ch = t >> (LOGL - 2);
  u16* b = base + (((size_t)((ch & 1) * 1536 + (ch >> 1) * 1024)) << LOGL);
  return (float2*)b + (t & (L / 4 - 1));
}
__device__ __forceinline__ void ld4(const float2* q, float2 (&e)[4]) {
  const float4 a = *(const float4*)q, b = *(const float4*)(q + 2);
  e[0] = make_float2(a.x, a.y); e[1] = make_float2(a.z, a.w); e[2] = make_float2(b.x, b.y); e[3] = make_float2(b.z, b.w);
}
__device__ __forceinline__ void st4(float2* q, const float2 (&e)[4]) {
  *(float4*)q = make_float4(e[0].x, e[0].y, e[1].x, e[1].y);
  *(float4*)(q + 2) = make_float4(e[2].x, e[2].y, e[3].x, e[3].y);
}
template <int LOGL, int SRC> __device__ __forceinline__ void hy_a4(const HyCtx c, int t, float2 (&e)[4]) {
  constexpr int L = 1 << LOGL;
  if (SRC == 0) {
    const u16* va = c.base + ((size_t)1024 << LOGL);
    const u16* vb = c.base + ((size_t)(1536 + 1024) << LOGL);
    float sa[4], sb[4];
    short_conv4(va, t, L, c.w0, c.w1, c.w2, c.bs, sa);
    short_conv4(vb, t, L, c.w0, c.w1, c.w2, c.bs, sb);
#pragma unroll
    for (int k = 0; k < 4; ++k) e[k] = make_float2(sa[k], sb[k]);
  } else {
    ld4(c.zin + t, e);
  }
}

struct HyPost { const u16 *xa, *xb; float w0, w1, w2, bs, bias; };
template <int LOGL, int STASH> __device__ __forceinline__ float2* hy_stash(float2* yst, u16* base, int t) {
  return (STASH == 0) ? (yst + t) : hy_zptr<LOGL>(base, t);
}
template <int LOGL, int SRC, int STASH>
__device__ __forceinline__ void long_conv(const HyCtx c, float2* yst, const float2* KE, const float2* KO, float2* buf, const HyPost pp) {
  constexpr int L = 1 << LOGL, NQ = L / 1024;
  const int tid = ltid();
#pragma unroll 4
  for (int i = 0; i < NQ; ++i) {
    const int t = 4 * (tid + 256 * i);
    float2 a[4];
    hy_a4<LOGL, SRC>(c, t, a);
#pragma unroll
    for (int k = 0; k < 4; ++k) buf[PADI(t) + k] = a[k];
  }
  __syncthreads();
  fft_fwd_head<LOGL>(buf);
  fft_mid<LOGL>(buf, KE);
  fft_inv_tail<LOGL>(buf);
#pragma unroll 4
  for (int i = 0; i < NQ; ++i) {
    const int t = 4 * (tid + 256 * i);
    float2 v[4];
#pragma unroll
    for (int k = 0; k < 4; ++k) v[k] = buf[PADI(t) + k];
    st4(hy_stash<LOGL, STASH>(yst, c.base, t), v);
  }
  __syncthreads();
#pragma unroll 4
  for (int i = 0; i < NQ; ++i) {
    const int t = 4 * (tid + 256 * i);
    float2 a[4];
    hy_a4<LOGL, SRC>(c, t, a);
#pragma unroll
    for (int k = 0; k < 4; ++k) buf[PADI(t) + k] = cmul(a[k], twid((float)(t + k) * (1.f / (float)(2 * L))));
  }
  __syncthreads();
  fft_fwd_head<LOGL>(buf);
  fft_mid<LOGL>(buf, KO);
  fft_inv_tail<LOGL>(buf);
#pragma unroll 4
  for (int i = 0; i < NQ; ++i) {
    const int t = 4 * (tid + 256 * i);
    float2 y[4], a[4];
    float xa[4], xb_[4];
    ld4(hy_stash<LOGL, STASH>(yst, c.base, t), y);
    hy_a4<LOGL, SRC>(c, t, a);
    short_conv4(pp.xa, t, L, pp.w0, pp.w1, pp.w2, pp.bs, xa);
    short_conv4(pp.xb, t, L, pp.w0, pp.w1, pp.w2, pp.bs, xb_);
#pragma unroll
    for (int k = 0; k < 4; ++k) {
      const float2 v = cmulc(buf[PADI(t) + k], twid((float)(t + k) * (1.f / (float)(2 * L))));
      y[k] = make_float2((y[k].x + v.x + pp.bias * a[k].x) * xa[k], (y[k].y + v.y + pp.bias * a[k].y) * xb_[k]);
    }
    st4(hy_stash<LOGL, STASH>(yst, c.base, t), y);
  }
  __syncthreads();
}

template <int LOGL> __device__ void hyena_job(const Params& p, int e, int c, int b0, char* smem) {
  constexpr int L = 1 << LOGL, NQ = L / 1024;
  float2* buf = (float2*)smem;
  const int tid = ltid();
  float2* yst = (float2*)(p.ws + OFF_YST) + (size_t)blockIdx.x * 8192;
  u16* Ut = (u16*)(p.ws + OFF_UT) + (LOGL == 12 ? (size_t)TPR * 1536 : 0);
  u16* x1a = Ut + (((size_t)(b0 * 1536 + c)) << LOGL);
  u16* x1b = Ut + (((size_t)((b0 + 1) * 1536 + c)) << LOGL);
  u16* x2a = x1a + ((size_t)512 << LOGL); u16* x2b = x1b + ((size_t)512 << LOGL);
  const float* cw = p.hy_conv_w + (size_t)e * 3 * 1536;
  const float* cb = p.hy_conv_b + (size_t)e * 1536;
  const float bias0 = p.hy_bias[(size_t)e * 1024 + c], bias1 = p.hy_bias[(size_t)e * 1024 + 512 + c];
  HyCtx cx;
  cx.base = x1a; cx.zin = yst;
  cx.w0 = cw[1024 + c]; cx.w1 = cw[1536 + 1024 + c]; cx.w2 = cw[3072 + 1024 + c]; cx.bs = cb[1024 + c];
  {
    HyPost pp; pp.xa = x1a; pp.xb = x1b; pp.w0 = cw[c]; pp.w1 = cw[1536 + c]; pp.w2 = cw[3072 + c]; pp.bs = cb[c]; pp.bias = bias0;
    long_conv<LOGL, 0, 0>(cx, yst, kf_ptr<LOGL>(p, 0, c, 0), kf_ptr<LOGL>(p, 0, c, 1), buf, pp);
  }
  {
    const int col = 512 + c;
    HyPost pp; pp.xa = x2a; pp.xb = x2b; pp.w0 = cw[col]; pp.w1 = cw[1536 + col]; pp.w2 = cw[3072 + col]; pp.bs = cb[col]; pp.bias = bias1;
    long_conv<LOGL, 1, 1>(cx, yst, kf_ptr<LOGL>(p, 1, c, 0), kf_ptr<LOGL>(p, 1, c, 1), buf, pp);
  }
  __syncthreads();
#pragma unroll 4
  for (int i = 0; i < NQ; ++i) {
    const int t = 4 * (tid + 256 * i);
    float2 y[4];
    ld4(hy_zptr<LOGL>(cx.base, t), y);
    uint2 oa, ob;
    oa.x = pack2(y[0].x, y[1].x); oa.y = pack2(y[2].x, y[3].x);
    ob.x = pack2(y[0].y, y[1].y); ob.y = pack2(y[2].y, y[3].y);
    *(uint2*)(x2a + t) = oa;
    *(uint2*)(x2b + t) = ob;
  }
}

__device__ void attn_item(const Params& p, int item, char* smem) {
  const int tid = ltid(), lane = tid & 63, wave = tid >> 6, l15 = lane & 15, g = lane >> 4;
  int b, h, qb, LOG; size_t tok0, vtb;
  if (item < 4096) { qb = item & 63; h = (item >> 6) & 7; b = item >> 9; LOG = 13; tok0 = (size_t)b * 8192; vtb = ((size_t)((b * 8 + h) * 64)) << 13; }
  else { const int it = item - 4096; qb = it & 31; h = (it >> 5) & 7; b = it >> 8; LOG = 12; tok0 = TPR + (size_t)b * 4096;
         vtb = (size_t)TPR * 512 + (((size_t)((b * 8 + h) * 64)) << 12); }
  const int nkt = (1 << LOG) >> 6;
  const u16* Qn = (const u16*)(p.ws + OFF_Q);
  const u16* Qr = Qn + (size_t)NT * 512;
  const u16* knb = (const u16*)(p.ws + OFF_K) + tok0 * 512 + h * 64;
  const u16* krb = (const u16*)(p.ws + OFF_KR) + tok0 * 32;
  const u16* vbase = (const u16*)(p.ws + OFF_VT) + vtb;
  const size_t q0 = tok0 + (size_t)qb * 128 + wave * 32;
  bf16x8 qf[2][3];
#pragma unroll
  for (int qt = 0; qt < 2; ++qt)
#pragma unroll
    for (int ks = 0; ks < 3; ++ks) qf[qt][ks] = (ks < 2) ? *(const bf16x8*)(Qn + (q0 + qt * 16 + l15) * 512 + h * 64 + ks * 32 + g * 8)
                                                  : *(const bf16x8*)(Qr + (q0 + qt * 16 + l15) * 256 + h * 32 + g * 8);
#define KKEY(i) ((tid + 256 * (i)) / 12)
#define KCH(i) ((tid + 256 * (i)) % 12)
#define KSRC(kt_, i) ((KCH(i) < 8) ? (knb + (size_t)((kt_) * 64 + KKEY(i)) * 512 + KCH(i) * 8) : (krb + (size_t)((kt_) * 64 + KKEY(i)) * 32 + (KCH(i) - 8) * 8))
  const int vd0 = tid >> 3, vch = tid & 7;
  u32x4 rk0, rk1, rk2, rv0, rv1;
  rk0 = *(const u32x4*)KSRC(0, 0); rk1 = *(const u32x4*)KSRC(0, 1); rk2 = *(const u32x4*)KSRC(0, 2);
  rv0 = *(const u32x4*)(vbase + ((size_t)(vd0) << LOG) + vch * 8);
  rv1 = *(const u32x4*)(vbase + ((size_t)(vd0 + 32) << LOG) + vch * 8);
  *(u32x4*)(smem + KKEY(0) * 208 + KCH(0) * 16) = rk0;
  *(u32x4*)(smem + KKEY(1) * 208 + KCH(1) * 16) = rk1;
  *(u32x4*)(smem + KKEY(2) * 208 + KCH(2) * 16) = rk2;
  *(u32x4*)(smem + 13312 + (vd0) * 144 + vch * 16) = rv0;
  *(u32x4*)(smem + 13312 + (vd0 + 32) * 144 + vch * 16) = rv1;
  __syncthreads();
  f32x4 o[4][2];
#pragma unroll
  for (int dt = 0; dt < 4; ++dt) { o[dt][0] = f32x4{0.f, 0.f, 0.f, 0.f}; o[dt][1] = f32x4{0.f, 0.f, 0.f, 0.f}; }
  float mrun[2] = {-1e30f, -1e30f}, lrun[2] = {0.f, 0.f};
  for (int kt = 0; kt < nkt; ++kt) {
    const int ktn = (kt + 1 < nkt) ? (kt + 1) : kt;
    rk0 = gload128(KSRC(ktn, 0)); rk1 = gload128(KSRC(ktn, 1)); rk2 = gload128(KSRC(ktn, 2));
    rv0 = gload128(vbase + ((size_t)(vd0) << LOG) + ktn * 64 + vch * 8);
    rv1 = gload128(vbase + ((size_t)(vd0 + 32) << LOG) + ktn * 64 + vch * 8);
    __builtin_amdgcn_sched_barrier(0);
    const char* ks_ = smem + (kt & 1) * 22528;
    const char* vs_ = ks_ + 13312;
    f32x4 st[4][2];
#pragma unroll
    for (int kti = 0; kti < 4; ++kti) { st[kti][0] = f32x4{0.f, 0.f, 0.f, 0.f}; st[kti][1] = f32x4{0.f, 0.f, 0.f, 0.f}; }
    __builtin_amdgcn_s_setprio(1);
#pragma unroll
    for (int ks = 0; ks < 3; ++ks)
#pragma unroll
      for (int kti = 0; kti < 4; ++kti) {
        const bf16x8 kf = *(const bf16x8*)(ks_ + (kti * 16 + l15) * 208 + (ks * 4 + g) * 16);
        st[kti][0] = __builtin_amdgcn_mfma_f32_16x16x32_bf16(kf, qf[0][ks], st[kti][0], 0, 0, 0);
        st[kti][1] = __builtin_amdgcn_mfma_f32_16x16x32_bf16(kf, qf[1][ks], st[kti][1], 0, 0, 0);
      }
    __builtin_amdgcn_s_setprio(0);
    bf16x8 pfa[2], pfb[2];
#pragma unroll
    for (int qt = 0; qt < 2; ++qt) {
      float mx = st[0][qt][0];
#pragma unroll
      for (int kti = 0; kti < 4; ++kti)
#pragma unroll
        for (int j = 0; j < 4; ++j) mx = fmaxf(mx, st[kti][qt][j]);
      mx = fmaxf(mx, __shfl_xor(mx, 16));
      mx = fmaxf(mx, __shfl_xor(mx, 32));
      const float mnew = fmaxf(mrun[qt], mx);
      const float alpha = __builtin_amdgcn_exp2f(mrun[qt] - mnew);
      mrun[qt] = mnew;
      float ls = 0.f;
      u32x4 pw0, pw1;
#pragma unroll
      for (int kti = 0; kti < 4; ++kti) {
        const float p0 = __builtin_amdgcn_exp2f(st[kti][qt][0] - mnew), p1 = __builtin_amdgcn_exp2f(st[kti][qt][1] - mnew);
        const float p2 = __builtin_amdgcn_exp2f(st[kti][qt][2] - mnew), p3 = __builtin_amdgcn_exp2f(st[kti][qt][3] - mnew);
        ls += (p0 + p1) + (p2 + p3);
        const unsigned wa = pack2(p0, p1), wb = pack2(p2, p3);
        if (kti == 0) { pw0[0] = wa; pw0[1] = wb; } else if (kti == 1) { pw0[2] = wa; pw0[3] = wb; }
        else if (kti == 2) { pw1[0] = wa; pw1[1] = wb; } else { pw1[2] = wa; pw1[3] = wb; }
      }
      if (qt == 0) { pfa[0] = __builtin_bit_cast(bf16x8, pw0); pfa[1] = __builtin_bit_cast(bf16x8, pw1); }
      else { pfb[0] = __builtin_bit_cast(bf16x8, pw0); pfb[1] = __builtin_bit_cast(bf16x8, pw1); }
      lrun[qt] = lrun[qt] * alpha + ls;
#pragma unroll
      for (int dt = 0; dt < 4; ++dt) {
        o[dt][qt][0] *= alpha; o[dt][qt][1] *= alpha; o[dt][qt][2] *= alpha; o[dt][qt][3] *= alpha;
      }
    }
    __builtin_amdgcn_s_setprio(1);
#pragma unroll
    for (int kk = 0; kk < 2; ++kk)
#pragma unroll
      for (int dt = 0; dt < 4; ++dt) {
        const char* va = vs_ + (dt * 16 + l15) * 144 + (kk * 32 + g * 4) * 2;
        const s16x4 lo = *(const s16x4*)va;
        const s16x4 hi = *(const s16x4*)(va + 32);
        const bf16x8 vf = __builtin_shufflevector(lo, hi, 0, 1, 2, 3, 4, 5, 6, 7);
        o[dt][0] = __builtin_amdgcn_mfma_f32_16x16x32_bf16(vf, pfa[kk], o[dt][0], 0, 0, 0);
        o[dt][1] = __builtin_amdgcn_mfma_f32_16x16x32_bf16(vf, pfb[kk], o[dt][1], 0, 0, 0);
      }
    __builtin_amdgcn_s_setprio(0);
    __builtin_amdgcn_sched_barrier(0);
    vm_wait0();
    {
      char* dk = smem + ((kt + 1) & 1) * 22528;
      *(u32x4*)(dk + KKEY(0) * 208 + KCH(0) * 16) = rk0;
      *(u32x4*)(dk + KKEY(1) * 208 + KCH(1) * 16) = rk1;
      *(u32x4*)(dk + KKEY(2) * 208 + KCH(2) * 16) = rk2;
      *(u32x4*)(dk + 13312 + (vd0) * 144 + vch * 16) = rv0;
      *(u32x4*)(dk + 13312 + (vd0 + 32) * 144 + vch * 16) = rv1;
    }
    __syncthreads();
  }
  u16* MIX = (u16*)(p.ws + OFF_MIX);
#pragma unroll
  for (int qt = 0; qt < 2; ++qt) {
    float l = lrun[qt];
    l += __shfl_xor(l, 16); l += __shfl_xor(l, 32);
    const float inv = 1.f / l;
    const size_t row = q0 + qt * 16 + l15;
#pragma unroll
    for (int dt = 0; dt < 4; ++dt) {
      uint2 pk;
      pk.x = pack2(o[dt][qt][0] * inv, o[dt][qt][1] * inv);
      pk.y = pack2(o[dt][qt][2] * inv, o[dt][qt][3] * inv);
      *(uint2*)(MIX + row * 1024 + 512 + h * 64 + dt * 16 + g * 4) = pk;
    }
  }
}

__device__ void ropek_job(const Params& p, int job) {
  const int tid = ltid();
  const int row = job * 16 + (tid >> 4), j = tid & 15;
  const u16* Pq = (const u16*)(p.ws + OFF_PQ) + (size_t)row * 768 + 640;
  const float* rc = (const float*)(p.ws + OFF_SMALL + ROPEC_O);
  const float* rsn = (const float*)(p.ws + OFF_SMALL + ROPES_O);
  const int pos = seq_pos(row);
  const float c = rc[pos * 16 + j], s = rsn[pos * 16 + j];
  const float x1 = bf2f(Pq[j]), x2 = bf2f(Pq[16 + j]);
  const u16 o1 = f2bf(x1 * c - x2 * s), o2 = f2bf(x1 * s + x2 * c);
  u16* Kr = (u16*)(p.ws + OFF_KR) + (size_t)row * 32;
  Kr[j] = o1; Kr[16 + j] = o2;
}

__device__ void ztrans_item(const Params& p, int item, char* smem) {
  u16* sm = (u16*)smem;
  const int tid = ltid();
  const int tt = item >> 3, ct = item & 7;
  const int row0 = tt * 64, c0 = ct * 64;
  const u16* Ut = (const u16*)(p.ws + OFF_UT);
  {
    const int cc = tid >> 2, tq = (tid & 3) * 16;
    const u16* src = Ut + ut_index(row0 + tq, 512 + c0 + cc);
    const uint4 v0 = *(const uint4*)src, v1 = *(const uint4*)(src + 8);
    *(uint4*)(sm + cc * 72 + tq) = v0;
    *(uint4*)(sm + cc * 72 + tq + 8) = v1;
  }
  __syncthreads();
  {
    const int t = tid >> 2, cq = (tid & 3) * 16;
    unsigned w[8];
#pragma unroll
    for (int i = 0; i < 8; ++i) w[i] = (unsigned)sm[(cq + 2 * i) * 72 + t] | ((unsigned)sm[(cq + 2 * i + 1) * 72 + t] << 16);
    u16* dst = (u16*)(p.ws + OFF_MIX) + (size_t)(row0 + t) * 1024 + c0 + cq;
    *(uint4*)dst = make_uint4(w[0], w[1], w[2], w[3]);
    *(uint4*)(dst + 8) = make_uint4(w[4], w[5], w[6], w[7]);
  }
  __syncthreads();
}

__device__ void rs_rows(const Params& p, size_t part_off) {
  const float* part = (const float*)(p.ws + part_off);
  float* RS = (float*)(p.ws + OFF_SMALL + SS_O);
  for (int row = blockIdx.x * 256 + ltid(); row < NT; row += gridDim.x * 256) RS[row] = row_rs16(part, row);
}

template <int HW> __device__ __forceinline__ void pooldiff_body(const Params& p, int row, int ch) {
  const float* RS = (const float*)(p.ws + OFF_SMALL + SS_O);
  const u16* xb = (const u16*)(p.ws + OFF_XB);
  const int L = row < TPR ? 8192 : 4096;
  const int pos = seq_pos(row);
  float acc[8] = {0.f, 0.f, 0.f, 0.f, 0.f, 0.f, 0.f, 0.f};
  float self[8] = {0.f, 0.f, 0.f, 0.f, 0.f, 0.f, 0.f, 0.f};
#pragma unroll
  for (int d = -HW; d < HW; ++d) {
    const int q = pos + d;
    const bool ok = (q >= 0) && (q < L);
    const int r = ok ? (row + d) : row;
    const float rs = ok ? RS[r] : 0.f;
    const uint4 v = *(const uint4*)(xb + (size_t)r * 1024 + ch * 8);
    const unsigned w[4] = {v.x, v.y, v.z, v.w};
#pragma unroll
    for (int i = 0; i < 4; ++i) {
      const float f0 = __uint_as_float(w[i] << 16) * rs, f1 = __uint_as_float(w[i] & 0xffff0000u) * rs;
      acc[2 * i] += f0; acc[2 * i + 1] += f1;
      if (d == 0) { self[2 * i] = f0; self[2 * i + 1] = f1; }
    }
  }
  const int lo = max(pos - HW, 0), hi = min(pos + HW, L);
  const float invn = 1.f / (float)(hi - lo);
  uint4 o;
  o.x = pack2(acc[0] * invn - self[0], acc[1] * invn - self[1]);
  o.y = pack2(acc[2] * invn - self[2], acc[3] * invn - self[3]);
  o.z = pack2(acc[4] * invn - self[4], acc[5] * invn - self[5]);
  o.w = pack2(acc[6] * invn - self[6], acc[7] * invn - self[7]);
  *(uint4*)((u16*)(p.ws + OFF_D) + (size_t)row * 1024 + ch * 8) = o;
}
__device__ void pooldiff_job(const Params& p, int layer, int job) {
  (void)layer;
  const int tid = ltid();
  const int row = job * 2 + (tid >> 7), ch = tid & 127;
  const int gi = ch >> 5;
  if (gi == 0) pooldiff_body<1>(p, row, ch);
  else if (gi == 1) pooldiff_body<2>(p, row, ch);
  else if (gi == 2) pooldiff_body<4>(p, row, ch);
  else pooldiff_body<8>(p, row, ch);
}

__device__ void final_rows(const Params& p) {
  int G = gridDim.x; asm volatile("" : "+s"(G));
  const int bid = blockIdx.x, tid = ltid();
  const float* RSv = (const float*)(p.ws + OFF_SMALL + SS_O);
  const float4 gv = *(const float4*)(p.final_norm + tid * 4);
  for (int row = bid; row < NT; row += G) {
    const float rs = RSv[row];
    float4 v = *(float4*)(p.out + (size_t)row * 1024 + tid * 4);
    v.x *= rs * gv.x; v.y *= rs * gv.y; v.z *= rs * gv.z; v.w *= rs * gv.w;
    *(float4*)(p.out + (size_t)row * 1024 + tid * 4) = v;
  }
}

enum { K_PREP, K_E1A, K_E1, K_E2A, K_E2B, K_E2C, K_E2D, K_E3A, K_E3H13, K_E3H12, K_E3B, K_E4, K_RSA, K_M1, K_M2, K_RSB, K_O1, K_O2 , K_FINAL };
constexpr int NPHASE = 1 + 2 * (15 + 6) + 1;
__device__ __forceinline__ void phase_decode(int ph, int& kind, int& layer) {
  if (ph == 0) { kind = K_PREP; layer = 0; return; }
  if (ph == NPHASE - 1) { kind = K_FINAL; layer = 0; return; }
  int q = ph - 1;
  const int pair = q / 21; q -= pair * 21;
  if (q < 15) { layer = pair * 2; kind = K_E1A + q; }
  else { layer = pair * 2 + 1; q -= 15; kind = (q == 0) ? K_O1 : (q == 1) ? K_O2 : (q == 2) ? K_RSA : (q == 3) ? K_M1 : (q == 4) ? K_M2 : K_RSB; }
}

__device__ void run_phase(const Params& p, int ph, char* smem) {
  int kind, layer;
  phase_decode(ph, kind, layer);
  int G = gridDim.x; asm volatile("" : "+s"(G));
  const int bid = blockIdx.x;
  const int e = layer >> 1;
#ifdef ONLY_KIND
  if (kind != ONLY_KIND) return;
#endif
  switch (kind) {
    case K_PREP: phase_prep(p, smem); break;
    case K_E1A: for (int j = bid; j < 192; j += G) h2_job(p, e, j, smem); break;
    case K_E1: for (int j = bid; j < 11520; j += G) tile_win(p, e, j, smem); break;
    case K_E2A:
      for (int j = bid; j < 1024; j += G) filt_job<13>(p, e, j >> 9, j & 511, smem);
      for (int j = bid; j < 1024; j += G) filt_job<12>(p, e, j >> 9, j & 511, smem);
      break;
    case K_E2B: for (int j = bid; j < 3840; j += G) tile_uq(p, e, j, smem); break;
    case K_E2C: for (int j = bid; j < 5120; j += G) tile_ukv(p, e, j, smem); break;
    case K_E2D: for (int j = bid; j < 5120; j += G) ropek_job(p, j); break;
    case K_E3A:
      if (G == 512) {
        const int x = bid & 7, slot = bid >> 3;
        for (int r = 0; r < 8; ++r) attn_item(p, ((r * 8 + x) << 6) | slot, smem);
        for (int r = 0; r < 2; ++r) attn_item(p, 4096 + (((r * 16 + x * 2 + (slot >> 5)) << 5) | (slot & 31)), smem);
      } else {
        for (int j = bid; j < 5120; j += G) attn_item(p, j, smem);
      }
      break;
    case K_E3H13: for (int j = bid; j < 2048; j += G) hyena_job<13>(p, e, j >> 2, (j & 3) * 2, smem); break;
    case K_E3H12: for (int j = bid; j < 1024; j += G) hyena_job<12>(p, e, j >> 1, (j & 1) * 2, smem); break;
    case K_E3B: for (int j = bid; j < 10240; j += G) ztrans_item(p, j, smem); break;
    case K_E4: for (int j = bid; j < 5120; j += G) tile_wout(p, layer, j, smem); break;
    case K_M1: for (int j = bid; j < 640 * 32; j += G) tile_mlp1(p, layer, j, smem); break;
    case K_M2: for (int j = bid; j < 5120; j += G) tile_mlp2(p, layer, j, smem); break;
    case K_RSA: rs_rows(p, OFF_PARTA); break;
    case K_RSB: rs_rows(p, OFF_PARTB); break;
    case K_O1: for (int j = bid; j < NT / 2; j += G) pooldiff_job(p, layer, j); break;
    case K_O2: for (int j = bid; j < 5120; j += G) tile_pool(p, layer, j, smem); break;
    case K_FINAL: final_rows(p); break;
  }
}


#define XB_TMO      128
#define XB_XCNT(j)  (256  + 64 * (j))
#define XB_XSUB(j)  (1280 + 64 * (j))
#define XB_XGEN(j)  (2304 + 64 * (j))
#define XB_TOP      3328
#define XB_TOPGEN   3392
#define XCD_BAR_WORDS 3456
#define XB_SPIN_CAP (1u << 22)
#define XB_LAS __attribute__((address_space(3)))
__device__ __forceinline__ unsigned xb_ld(unsigned* q) { return __hip_atomic_load(q, __ATOMIC_RELAXED, __HIP_MEMORY_SCOPE_AGENT); }
__device__ __forceinline__ unsigned xb_add(unsigned* q, unsigned v) { return __hip_atomic_fetch_add(q, v, __ATOMIC_RELAXED, __HIP_MEMORY_SCOPE_AGENT); }
__device__ __forceinline__ unsigned xb_xcc_id() { return (unsigned)__builtin_amdgcn_s_getreg((3 << 11) | 20) & 0xFu; }
#define XB_SPIN(cond, bar) do { unsigned _sp = 0; while (cond) { __builtin_amdgcn_s_sleep(1); \
    if ((++_sp & 255u) == 0u) { if (xb_ld(&(bar)[XB_TMO])) break; if (_sp > XB_SPIN_CAP) { atomicAdd(&(bar)[XB_TMO], 1u); break; } } } } while (0)
struct XcdBarrier { unsigned* bar; unsigned x; volatile XB_LAS unsigned* st; };
__device__ __forceinline__ XcdBarrier xcd_barrier_post(unsigned* bar, volatile XB_LAS unsigned* st) {
  XcdBarrier b; b.bar = bar; b.x = xb_xcc_id(); b.st = st;
  if (threadIdx.x == 0) (void)xb_add(&bar[XB_XCNT(b.x)], 1u);
  return b;
}
__device__ __forceinline__ void xcd_barrier_complete(unsigned* bar, unsigned x, unsigned& nloc, unsigned& nx) {
  const unsigned G = gridDim.x * gridDim.y * gridDim.z;
  unsigned sum, cnt, mine, sp = 0u;
  for (;;) {
    sum = 0u; cnt = 0u; mine = 0u;
#pragma unroll
    for (unsigned j = 0; j < 16; ++j) { const unsigned c = xb_ld(&bar[XB_XCNT(j)]); sum += c; cnt += (c > 0u) ? 1u : 0u; mine = (j == x) ? c : mine; }
    if (sum == G) break;
    __builtin_amdgcn_s_sleep(1);
    if ((++sp & 255u) == 0u) { if (xb_ld(&bar[XB_TMO])) break; if (sp > XB_SPIN_CAP) { atomicAdd(&bar[XB_TMO], 1u); break; } }
  }
  nloc = mine > 0u ? mine : 1u; nx = cnt > 0u ? cnt : 1u;
}
__device__ __forceinline__ void xcd_barrier(const XcdBarrier& b) {
  asm volatile("s_waitcnt vmcnt(0)" ::: "memory");
  __syncthreads();
  if (threadIdx.x == 0) {
    unsigned* bar = b.bar;
    __builtin_amdgcn_s_waitcnt(0);
    unsigned nloc = b.st[0], nx = b.st[1];
    if (nloc == 0u) { xcd_barrier_complete(bar, b.x, nloc, nx); b.st[0] = nloc; b.st[1] = nx; }
    const unsigned old = xb_add(&bar[XB_XSUB(b.x)], 1u);
    const unsigned gen = old / nloc;
    if (old + 1u == (gen + 1u) * nloc) {
      __builtin_amdgcn_fence(__ATOMIC_RELEASE, "agent");
      asm volatile("s_waitcnt vmcnt(0)" ::: "memory");
      const unsigned og = xb_add(&bar[XB_TOP], 1u);
      const unsigned tg = og / nx;
      if (og + 1u == (tg + 1u) * nx) xb_add(&bar[XB_TOPGEN], 1u);
      else XB_SPIN(xb_ld(&bar[XB_TOPGEN]) == tg, bar);
      __builtin_amdgcn_fence(__ATOMIC_ACQUIRE, "agent");
      xb_add(&bar[XB_XGEN(b.x)], 1u);
      asm volatile("s_waitcnt vmcnt(0)" ::: "memory");
    } else {
      XB_SPIN(xb_ld(&bar[XB_XGEN(b.x)]) == gen, bar);
      __builtin_amdgcn_fence(__ATOMIC_ACQUIRE, "agent");
      asm volatile("s_waitcnt vmcnt(0)" ::: "memory");
    }
  }
  __syncthreads();
}

__global__ void __launch_bounds__(256, 2) mega(Params p, int ph_lo, int ph_hi, int coop) {
  __shared__ __attribute__((aligned(16))) char smem[SMEM_BYTES];
  __shared__ __attribute__((aligned(16))) unsigned xb_st[4];
  if (threadIdx.x < 4) xb_st[threadIdx.x] = 0u;
  __syncthreads();
  XcdBarrier xb = xcd_barrier_post((unsigned*)(p.ws + OFF_BAR), (volatile XB_LAS unsigned*)xb_st);
  for (int ph = ph_lo; ph < ph_hi; ++ph) {
    run_phase(p, ph, smem);
    if (coop && ph + 1 < ph_hi) {
      if (ph == ph_lo) cg::this_grid().sync();
      else xcd_barrier(xb);
    }
  }
}

extern "C" void kernel_launch(void* const* d_in, const int* in_sizes, int n_in, void* d_out, int out_size, void* d_ws,
                              size_t ws_size, hipStream_t stream) {
  (void)in_sizes; (void)n_in; (void)out_size;
  if (ws_size < WS_NEED) { fprintf(stderr, "workspace too small: %zu < %zu\n", ws_size, (size_t)WS_NEED); return; }
  Params p;
  memset(&p, 0, sizeof(p));
  const float** pp = (const float**)&p;
  for (int i = 0; i < 24; ++i) pp[i] = (const float*)d_in[i];
  p.out = (float*)d_out;
  p.ws = (char*)d_ws;
  u16* W = (u16*)((char*)d_ws + OFF_W);
  int nt = 0, tiles = 0;
  auto add = [&](const float* src, u16* dst, const float* gk, const float* gn, int K, int N, int Npad, int perm) {
    ConvTask& t = p.tasks[nt++];
    t.src = src; t.dst = dst; t.gk = gk; t.gn = gn; t.K = K; t.N = N; t.Npad = Npad; t.perm = perm; t.tile0 = tiles; t.pad = 0;
    tiles += (K / 64) * (Npad / 64);
  };
  for (int i = 0; i < 4; ++i) {
    add(p.mlp_w1 + (size_t)i * 1024 * 4096, W + WM1_O + (size_t)i * 4096 * 1024, p.mlp_norm + i * 1024, nullptr, 1024, 4096, 4096, 0);
    add(p.mlp_w2 + (size_t)i * 4096 * 1024, W + WM2_O + (size_t)i * 4096 * 1024, nullptr, nullptr, 4096, 1024, 1024, 0);
  }
  for (int e = 0; e < 2; ++e) {
    add(p.w_in + (size_t)e * 1024 * 2208, W + WIN_O + (size_t)e * 2304 * 1024, p.mix_norm + (2 * e) * 1024, nullptr, 1024, 2208, 2304, 0);
    add(p.w_uq + (size_t)e * 384 * 768, W + WUQ_O + (size_t)e * 768 * 384, p.q_norm + e * 384, nullptr, 384, 768, 768, 1);
    add(p.w_ukv + (size_t)e * 256 * 1024, W + WUKV_O + (size_t)e * 1024 * 256, p.kv_norm + e * 256, nullptr, 256, 1024, 1024, 0);
    add(p.w_out + (size_t)e * 1024 * 1024, W + WOUT_O + (size_t)e * 1024 * 1024, nullptr, nullptr, 1024, 1024, 1024, 0);
  }
  for (int o = 0; o < 2; ++o)
    for (int gi = 0; gi < 4; ++gi)
      add(p.pool_w + (size_t)(o * 4 + gi) * 65536, W + WPOOL_O + (size_t)(o * 4 + gi) * 65536,
          p.mix_norm + (2 * o + 1) * 1024 + gi * 256, p.pool_scale + o * 1024 + gi * 256, 256, 256, 256, 0);
  p.ntasks = nt; p.total_conv_tiles = tiles;

  static int grid_blocks = 0;
  if (!grid_blocks) {
    int dev = 0, cus = 0, per_cu = 0;
    hipGetDevice(&dev);
    hipDeviceGetAttribute(&cus, hipDeviceAttributeMultiprocessorCount, dev);
    hipOccupancyMaxActiveBlocksPerMultiprocessor(&per_cu, mega, 256, 0);
    if (per_cu < 1) per_cu = 1;
    grid_blocks = cus * per_cu;
    if (grid_blocks > MAX_GRID) grid_blocks = MAX_GRID;
  }
#if MULTI_LAUNCH
  for (int ph = 0; ph < NPHASE; ++ph) hipLaunchKernelGGL(mega, dim3(grid_blocks), dim3(256), 0, stream, p, ph, ph + 1, 0);
#else
  hipMemsetAsync((char*)d_ws + OFF_BAR, 0, XCD_BAR_WORDS * sizeof(unsigned), stream);
  int lo = 0, hi = NPHASE, coop = 1;
  void* args[] = {&p, &lo, &hi, &coop};
  hipError_t err = hipLaunchCooperativeKernel((void*)mega, dim3(grid_blocks), dim3(256), args, 0, stream);
  if (err != hipSuccess) fprintf(stderr, "cooperative launch failed: %s (grid %d)\n", hipGetErrorString(err), grid_blocks);
#endif
}
```
